# Optimizing an MI355X kernel written in HIP

```python
import math
import jax, jax.numpy as jnp
from jax import lax
import numpy as np

D_MODEL = 1024
BATCH = 8
SEQ = 2048
DEPTH = 4
DEC_BATCH = 128
DEC_SEQ = 1
PAST_LEN = 8192
PAGE_SIZE = 128

F32 = jnp.float32
RET_HEADS = 4
RET_DK = 128
RET_DV = 128
RET_CHUNK = 128
ROPE_BASE = 10000.0
SSD_HEADS = 16
SSD_HEAD_DIM = 64
SSD_GROUPS = 2
SSD_STATE = 128
SSD_CONV = 4
SSD_CHUNK = 128
SSD_INNER = SSD_HEADS * SSD_HEAD_DIM
SSD_CONV_DIM = SSD_INNER + 2 * SSD_GROUPS * SSD_STATE
SWA_Q_HEADS = 8
SWA_KV_HEADS = 2
SWA_HEAD_DIM = 64
WINDOW = 128
SWA_QBLK = 128
N_BUCKETS = 32
BUCKET_MAX_DIST = 128
D_FF = ((8 * D_MODEL // 3 + 255) // 256) * 256
ALPHA = (2 * DEPTH) ** 0.25
BETA = (8 * DEPTH) ** -0.25
EPS = 1e-5
IN_SIZES = (RET_HEADS * RET_DK, RET_HEADS * RET_DK, RET_HEADS * RET_DV, RET_HEADS * RET_DV,
            SSD_INNER, SSD_CONV_DIM, SSD_HEADS,
            SWA_Q_HEADS * SWA_HEAD_DIM, SWA_KV_HEADS * SWA_HEAD_DIM, SWA_KV_HEADS * SWA_HEAD_DIM,
            3 * D_MODEL)
N_IN = sum(IN_SIZES)

kernel_name = 'hybrid_retention_ssd_swa_deepnorm_step'


def _offsets(sizes):
    out, t = [], 0
    for s in sizes[:-1]:
        t += s
        out.append(t)
    return out


def _layer_norm(x, g, b):
    xf = x.astype(F32)
    mu = jnp.mean(xf, -1, keepdims=True)
    var = jnp.mean(jnp.square(xf - mu), -1, keepdims=True)
    return ((xf - mu) * lax.rsqrt(var + EPS) * g.astype(F32) + b.astype(F32)).astype(x.dtype)


def _head_norm(o):
    mu = jnp.mean(o, -1, keepdims=True)
    var = jnp.mean(jnp.square(o - mu), -1, keepdims=True)
    return (o - mu) * lax.rsqrt(var + EPS)


def _group_rms(y, w):
    yg = y.reshape(y.shape[:-1] + (SSD_GROUPS, SSD_INNER // SSD_GROUPS))
    yg = yg * lax.rsqrt(jnp.mean(jnp.square(yg), -1, keepdims=True) + EPS)
    return yg.reshape(y.shape) * w.astype(F32)


def _rotary(x, pos):
    half = x.shape[-1] // 2
    inv = ROPE_BASE ** (-jnp.arange(half, dtype=F32) / half)
    ang = pos[:, None] * inv[None, :]
    cos = jnp.cos(ang)[None, :, None, :]
    sin = jnp.sin(ang)[None, :, None, :]
    xf = x.astype(F32)
    x1, x2 = xf[..., :half], xf[..., half:]
    return jnp.concatenate([x1 * cos - x2 * sin, x1 * sin + x2 * cos], -1)


def _retention(q, k, v, s0):
    bsz, L, H, dk = q.shape
    dv = v.shape[-1]
    c = RET_CHUNK if L % RET_CHUNK == 0 else L
    n = L // c
    lg = jnp.log(1.0 - 2.0 ** (-5.0 - jnp.arange(H, dtype=F32)))
    qc = q.reshape(bsz, n, c, H, dk)
    kc = k.reshape(bsz, n, c, H, dk)
    vc = v.reshape(bsz, n, c, H, dv).astype(F32)
    i = jnp.arange(c, dtype=F32)
    rel = i[:, None] - i[None, :]
    dmat = jnp.where(rel >= 0, jnp.exp(lg[:, None, None] * jnp.maximum(rel, 0.0)), 0.0)
    sc = jnp.einsum('bnihd,bnjhd->bnhij', qc, kc) * dmat
    o_intra = jnp.einsum('bnhij,bnjhv->bnihv', sc, vc)
    kdec = jnp.exp(lg[None, :] * (c - 1 - i)[:, None])
    kv = jnp.einsum('bnjhd,jh,bnjhv->nbhdv', kc, kdec, vc)
    cdec = jnp.exp(lg * c)[None, :, None, None]

    def step(s, kv_c):
        return cdec * s + kv_c, s

    s_fin, s_before = lax.scan(step, s0.astype(F32), kv)
    qdec = jnp.exp(lg[None, :] * (i + 1.0)[:, None])
    o_cross = jnp.einsum('bnihd,nbhdv,ih->bnihv', qc, s_before, qdec)
    return (o_intra + o_cross).reshape(bsz, L, H, dv), s_fin


def _causal_conv(xbc, buf, w, b):
    L = xbc.shape[1]
    ext = jnp.concatenate([buf.astype(xbc.dtype), xbc], axis=1)
    out = sum(w[t] * ext[:, t:t + L] for t in range(SSD_CONV)) + b
    return jax.nn.silu(out), ext[:, -(SSD_CONV - 1):]


def _ssd(x, dt, a, bm, cm, s0):
    bsz, L, H, P = x.shape
    G, N = bm.shape[2], bm.shape[3]
    hg = H // G
    c = SSD_CHUNK if L % SSD_CHUNK == 0 else L
    n = L // c
    xc = x.reshape(bsz, n, c, G, hg, P).astype(F32)
    dtc = dt.reshape(bsz, n, c, G, hg)
    bc = bm.reshape(bsz, n, c, G, N).astype(F32)
    cc = cm.reshape(bsz, n, c, G, N).astype(F32)
    cs = jnp.cumsum(dtc * a.reshape(G, hg), axis=2)
    seg = cs[:, :, :, None] - cs[:, :, None, :]
    causal = jnp.tril(jnp.ones((c, c), dtype=bool))[:, :, None, None]
    lmat = jnp.exp(jnp.where(causal, seg, -jnp.inf))
    cb = jnp.einsum('bcigs,bcjgs->bcijg', cc, bc)
    wmat = cb[..., None] * lmat * dtc[:, :, None]
    y_intra = jnp.einsum('bcijgh,bcjghp->bcighp', wmat, xc)
    dec_end = jnp.exp(cs[:, :, -1:] - cs)
    st = jnp.einsum('bcjgs,bcjgh,bcjghp->cbghps', bc, dec_end * dtc, xc)
    chunk_dec = jnp.exp(cs[:, :, -1]).transpose(1, 0, 2, 3)

    def step(s, inp):
        st_c, dec_c = inp
        return dec_c[..., None, None] * s + st_c, s

    s_fin, s_before = lax.scan(step, s0.astype(F32).reshape(bsz, G, hg, P, N), (st, chunk_dec))
    y_cross = jnp.einsum('bcigs,cbghps,bcigh->bcighp', cc, s_before, jnp.exp(cs))
    return (y_intra + y_cross).reshape(bsz, L, H, P), s_fin.reshape(bsz, H, P, N)


def _t5_bucket(dist):
    max_exact = N_BUCKETS // 2
    df = jnp.maximum(dist, 1).astype(F32)
    large = max_exact + (jnp.log(df / max_exact) / math.log(BUCKET_MAX_DIST / max_exact)
                         * (N_BUCKETS - max_exact)).astype(jnp.int32)
    large = jnp.minimum(large, N_BUCKETS - 1)
    return jnp.where(dist < max_exact, dist, large)


def _swa(q, k, v, kbuf, vbuf, buf_valid, sinks, rel_bias):
    bsz, L = q.shape[:2]
    G = SWA_Q_HEADS // SWA_KV_HEADS
    qs = SWA_QBLK if L % SWA_QBLK == 0 else L
    nb = L // qs
    k_ext = jnp.concatenate([kbuf.astype(k.dtype), k], axis=1)
    v_ext = jnp.concatenate([vbuf.astype(v.dtype), v], axis=1)
    kidx = (jnp.arange(nb) * qs)[:, None] + jnp.arange(qs + WINDOW)[None, :]
    kb = k_ext[:, kidx]
    vb = v_ext[:, kidx]
    qb = q.reshape(bsz, nb, qs, SWA_KV_HEADS, G, SWA_HEAD_DIM)
    s = jnp.einsum('bnqhgd,bnkhd->bnhgqk', qb, kb).astype(F32) * SWA_HEAD_DIM ** -0.5
    dist = jnp.arange(qs)[:, None] + WINDOW - jnp.arange(qs + WINDOW)[None, :]
    band = (dist >= 0) & (dist <= WINDOW)
    key_ok = (kidx >= WINDOW) | buf_valid
    mask = band[None] & key_ok[:, None, :]
    bias = rel_bias[_t5_bucket(jnp.maximum(dist, 0))].astype(F32)
    bias = bias.transpose(2, 0, 1).reshape(SWA_KV_HEADS, G, qs, qs + WINDOW)
    logits = jnp.where(mask[None, :, None, None], s + bias, -1e30)
    sink = jnp.broadcast_to(sinks.astype(F32).reshape(1, 1, SWA_KV_HEADS, G, 1, 1), logits.shape[:-1] + (1,))
    p = jax.nn.softmax(jnp.concatenate([logits, sink], axis=-1), axis=-1)[..., :-1]
    o = jnp.einsum('bnhgqk,bnkhd->bnqhgd', p, vb.astype(F32))
    o = o.reshape(bsz, L, SWA_Q_HEADS * SWA_HEAD_DIM).astype(q.dtype)
    return o, k_ext[:, -WINDOW:], v_ext[:, -WINDOW:]


def _layer(x, pos, s_ret, s_ssm, s_conv, kbuf, vbuf, buf_valid, rel_bias, p):
    (w_in, conv_w, conv_b, dt_bias, a_log, d_skip, ssd_norm_w, sinks,
     w_br_ret, w_br_ssd, w_br_swa, w_out, ln1_g, ln1_b, ln2_g, ln2_b,
     w_ffn_gate, w_ffn_up, w_ffn_down) = p
    bsz, L, _ = x.shape
    u = x @ w_in
    (q_r, k_r, v_r, g_r, z, xbc, dt_raw, q_c, k_c, v_c, gates) = jnp.split(u, _offsets(IN_SIZES), axis=-1)

    q_r = _rotary(q_r.reshape(bsz, L, RET_HEADS, RET_DK), pos)
    k_r = _rotary(k_r.reshape(bsz, L, RET_HEADS, RET_DK), pos) * RET_DK ** -0.5
    o_r, s_ret_new = _retention(q_r, k_r, v_r.reshape(bsz, L, RET_HEADS, RET_DV), s_ret)
    o_r = _head_norm(o_r).reshape(bsz, L, RET_HEADS * RET_DV) * jax.nn.silu(g_r.astype(F32))
    br_a = o_r.astype(x.dtype) @ w_br_ret

    xbc, s_conv_new = _causal_conv(xbc, s_conv, conv_w, conv_b)
    xs, bm, cm = jnp.split(xbc, [SSD_INNER, SSD_INNER + SSD_GROUPS * SSD_STATE], axis=-1)
    xs = xs.reshape(bsz, L, SSD_HEADS, SSD_HEAD_DIM)
    dt = jax.nn.softplus(dt_raw.astype(F32) + dt_bias.astype(F32))
    a = -jnp.exp(a_log.astype(F32))
    y, s_ssm_new = _ssd(xs, dt, a, bm.reshape(bsz, L, SSD_GROUPS, SSD_STATE),
                        cm.reshape(bsz, L, SSD_GROUPS, SSD_STATE), s_ssm)
    y = y + d_skip.astype(F32)[:, None] * xs.astype(F32)
    y = y.reshape(bsz, L, SSD_INNER) * jax.nn.silu(z.astype(F32))
    br_b = _group_rms(y, ssd_norm_w).astype(x.dtype) @ w_br_ssd

    o_c, kbuf_new, vbuf_new = _swa(q_c.reshape(bsz, L, SWA_Q_HEADS, SWA_HEAD_DIM),
                                   k_c.reshape(bsz, L, SWA_KV_HEADS, SWA_HEAD_DIM),
                                   v_c.reshape(bsz, L, SWA_KV_HEADS, SWA_HEAD_DIM),
                                   kbuf, vbuf, buf_valid, sinks, rel_bias)
    br_c = o_c @ w_br_swa

    g_a, g_b, g_c = jnp.split(jax.nn.sigmoid(gates), 3, axis=-1)
    mix = (g_a * br_a + g_b * br_b + g_c * br_c) @ w_out
    x = _layer_norm(ALPHA * x + mix, ln1_g, ln1_b)
    ffn = (jax.nn.silu(x @ w_ffn_gate) * (x @ w_ffn_up)) @ w_ffn_down
    x = _layer_norm(ALPHA * x + ffn, ln2_g, ln2_b)
    return x, (s_ret_new.astype(s_ret.dtype), s_ssm_new.astype(s_ssm.dtype),
               s_conv_new.astype(s_conv.dtype), kbuf_new.astype(kbuf.dtype), vbuf_new.astype(vbuf.dtype))


def _trunk(x, pos, states, buf_valid, rel_bias, params):
    new = [[], [], [], [], []]
    for l in range(DEPTH):
        p = tuple(w[l] for w in params)
        x, st = _layer(x, pos, states[0][l], states[1][l], states[2][l], states[3][l], states[4][l],
                       buf_valid, rel_bias, p)
        for j in range(5):
            new[j].append(st[j])
    return x, [jnp.stack(s) for s in new]


def setup_inputs(seed: int = 0) -> dict:
    key = jax.random.key(seed)
    ks = jax.random.split(key, 32)

    def nrm(k, shape, scale):
        return jax.random.normal(k, shape, F32) * scale

    dt0 = jnp.exp(jax.random.uniform(ks[10], (DEPTH, SSD_HEADS), F32, math.log(1e-3), math.log(1e-1)))
    return {
        'x_prompt': nrm(ks[0], (BATCH, SEQ, D_MODEL), 1.0),
        'x_sample': nrm(ks[1], (DEC_BATCH, DEC_SEQ, D_MODEL), 1.0),
        'state_ret': nrm(ks[2], (DEPTH, DEC_BATCH, RET_HEADS, RET_DK, RET_DV), 1.0),
        'state_ssm': nrm(ks[3], (DEPTH, DEC_BATCH, SSD_HEADS, SSD_HEAD_DIM, SSD_STATE), 0.5),
        'state_conv': nrm(ks[4], (DEPTH, DEC_BATCH, SSD_CONV - 1, SSD_CONV_DIM), 1.0),
        'cache_swa_k': nrm(ks[5], (DEPTH, DEC_BATCH, WINDOW, SWA_KV_HEADS, SWA_HEAD_DIM), 1.0),
        'cache_swa_v': nrm(ks[6], (DEPTH, DEC_BATCH, WINDOW, SWA_KV_HEADS, SWA_HEAD_DIM), 1.0),
        'w_in': nrm(ks[7], (DEPTH, D_MODEL, N_IN), D_MODEL ** -0.5),
        'conv_w': nrm(ks[8], (DEPTH, SSD_CONV, SSD_CONV_DIM), SSD_CONV ** -0.5),
        'conv_b': nrm(ks[9], (DEPTH, SSD_CONV_DIM), 0.02),
        'dt_bias': dt0 + jnp.log(-jnp.expm1(-dt0)),
        'a_log': jnp.log(jax.random.uniform(ks[11], (DEPTH, SSD_HEADS), F32, 1.0, 16.0)),
        'd_skip': 1.0 + nrm(ks[12], (DEPTH, SSD_HEADS), 0.1),
        'ssd_norm_w': 1.0 + nrm(ks[13], (DEPTH, SSD_INNER), 0.05),
        'sinks': nrm(ks[14], (DEPTH, SWA_Q_HEADS), 0.5),
        'rel_bias': nrm(ks[15], (N_BUCKETS, SWA_Q_HEADS), 0.2),
        'w_br_ret': nrm(ks[16], (DEPTH, RET_HEADS * RET_DV, D_MODEL), (RET_HEADS * RET_DV) ** -0.5 * BETA),
        'w_br_ssd': nrm(ks[17], (DEPTH, SSD_INNER, D_MODEL), SSD_INNER ** -0.5 * BETA),
        'w_br_swa': nrm(ks[18], (DEPTH, SWA_Q_HEADS * SWA_HEAD_DIM, D_MODEL), (SWA_Q_HEADS * SWA_HEAD_DIM) ** -0.5 * BETA),
        'w_out': nrm(ks[19], (DEPTH, D_MODEL, D_MODEL), D_MODEL ** -0.5 * BETA),
        'ln1_g': 1.0 + nrm(ks[20], (DEPTH, D_MODEL), 0.05),
        'ln1_b': nrm(ks[21], (DEPTH, D_MODEL), 0.02),
        'ln2_g': 1.0 + nrm(ks[22], (DEPTH, D_MODEL), 0.05),
        'ln2_b': nrm(ks[23], (DEPTH, D_MODEL), 0.02),
        'w_ffn_gate': nrm(ks[24], (DEPTH, D_MODEL, D_FF), D_MODEL ** -0.5),
        'w_ffn_up': nrm(ks[25], (DEPTH, D_MODEL, D_FF), D_MODEL ** -0.5 * BETA),
        'w_ffn_down': nrm(ks[26], (DEPTH, D_FF, D_MODEL), D_FF ** -0.5 * BETA),
    }


def reference(x_prompt, x_sample, state_ret, state_ssm, state_conv, cache_swa_k, cache_swa_v,
              w_in, conv_w, conv_b, dt_bias, a_log, d_skip, ssd_norm_w, sinks, rel_bias,
              w_br_ret, w_br_ssd, w_br_swa, w_out, ln1_g, ln1_b, ln2_g, ln2_b,
              w_ffn_gate, w_ffn_up, w_ffn_down):
    params = (w_in, conv_w, conv_b, dt_bias, a_log, d_skip, ssd_norm_w, sinks,
              w_br_ret, w_br_ssd, w_br_swa, w_out, ln1_g, ln1_b, ln2_g, ln2_b,
              w_ffn_gate, w_ffn_up, w_ffn_down)
    bsz, dtp = x_prompt.shape[0], x_prompt.dtype
    empty = (jnp.zeros((DEPTH, bsz) + state_ret.shape[2:], dtp),
             jnp.zeros((DEPTH, bsz) + state_ssm.shape[2:], dtp),
             jnp.zeros((DEPTH, bsz) + state_conv.shape[2:], dtp),
             jnp.zeros((DEPTH, bsz) + cache_swa_k.shape[2:], dtp),
             jnp.zeros((DEPTH, bsz) + cache_swa_v.shape[2:], dtp))
    pos_p = jnp.arange(x_prompt.shape[1], dtype=F32)
    y_prompt, st_p = _trunk(x_prompt, pos_p, empty, False, rel_bias, params)
    ret_p, ssm_p, conv_p, k_p, v_p = st_p
    pos_s = PAST_LEN + jnp.arange(x_sample.shape[1], dtype=F32)
    y_sample, st_s = _trunk(x_sample, pos_s, (state_ret, state_ssm, state_conv, cache_swa_k, cache_swa_v),
                            True, rel_bias, params)
    ret_s, ssm_s, conv_s, k_s, v_s = st_s
    return (y_prompt, y_sample, ret_p, ssm_p, conv_p, k_p, v_p, ret_s, ssm_s, conv_s, k_s, v_s)
```

```cpp
#include <hip/hip_runtime.h>
#include <hip/hip_cooperative_groups.h>
#include <cstdio>
#include <cstdint>
namespace cg = cooperative_groups;

#define LAS __attribute__((address_space(3)))
typedef unsigned short bf16_t;
typedef short bf16x8 __attribute__((ext_vector_type(8)));
typedef float f32x4 __attribute__((ext_vector_type(4)));
typedef float f32x2 __attribute__((ext_vector_type(2)));
typedef unsigned u32x4 __attribute__((ext_vector_type(4)));
typedef unsigned u32x2 __attribute__((ext_vector_type(2)));

constexpr int DM = 1024, NLAYER = 4;
constexpr int PB = 8, PL = 2048, MPR = PB * PL;
constexpr int SB = 128;
constexpr int MREAL = MPR + SB;
constexpr int MP = 16640;
constexpr int NIN = 8464, NU = 8704;
constexpr int DFF = 2816;
constexpr int KBR = 2048;
constexpr int U_QR = 0, U_KR = 512, U_VR = 1024, U_GR = 1536, U_Z = 2048, U_XBC = 3072, U_QC = 4608, U_KC = 5120, U_VC = 5248, U_GATE = 5376, U_DT = 8448;
constexpr float ALPHA = 1.681792830507429f;
constexpr float EPS = 1e-5f;
constexpr float PAST_POS = 8192.f;

constexpr size_t SZ_WIN = (size_t)NU * DM * 2, SZ_WBR = (size_t)DM * KBR * 2, SZ_WOUT = (size_t)DM * DM * 2, SZ_WGU = (size_t)2 * DFF * DM * 2, SZ_WDN = (size_t)DM * DFF * 2;
constexpr size_t SZ_WL = SZ_WIN + SZ_WBR + SZ_WOUT + SZ_WGU + SZ_WDN;
constexpr size_t WS_W = 0;
constexpr size_t WS_XB = WS_W + NLAYER * SZ_WL;
constexpr size_t WS_XF = WS_XB + (size_t)MP * DM * 2;
constexpr size_t WS_U = WS_XF + (size_t)MP * DM * 4;
constexpr size_t WS_ABR = WS_U + (size_t)MP * NU * 2;
constexpr size_t WS_MIX = WS_ABR + (size_t)MP * KBR * 2;
constexpr size_t WS_MIXB = WS_MIX + (size_t)MP * DM * 4;
constexpr size_t WS_KV = WS_MIXB + (size_t)MP * DM * 2;
constexpr size_t WS_ST = WS_KV + (size_t)8 * 4 * 16 * 16384 * 4;
constexpr size_t WS_CSL = WS_ST + (size_t)8 * 16 * 16 * 8192 * 4;
constexpr size_t WS_RSTD = WS_CSL + 8192;
constexpr size_t WS_END = WS_RSTD + (size_t)MP * 2 * 4;

constexpr size_t O_Y = 0;
constexpr size_t O_RETP = (size_t)MREAL * DM;
constexpr size_t O_SSMP = O_RETP + (size_t)4 * 8 * 4 * 16384;
constexpr size_t O_CONVP = O_SSMP + (size_t)4 * 8 * 16 * 8192;
constexpr size_t O_KP = O_CONVP + (size_t)4 * 8 * 3 * 1536;
constexpr size_t O_VP = O_KP + (size_t)4 * 8 * 128 * 128;
constexpr size_t O_RETS = O_VP + (size_t)4 * 8 * 128 * 128;
constexpr size_t O_SSMS = O_RETS + (size_t)4 * 128 * 4 * 16384;
constexpr size_t O_CONVS = O_SSMS + (size_t)4 * 128 * 16 * 8192;
constexpr size_t O_KS = O_CONVS + (size_t)4 * 128 * 3 * 1536;
constexpr size_t O_VS = O_KS + (size_t)4 * 128 * 128 * 128;
constexpr size_t O_END = O_VS + (size_t)4 * 128 * 128 * 128;

constexpr int LDS_BYTES = 147456;

__device__ const unsigned char T5_BUCKET[132] = {0, 1, 2, 3, 4, 5, 6, 7, 8, 9, 10, 11, 12, 13, 14, 15, 16, 16, 16, 17, 17, 18, 18, 18, 19, 19, 19, 20, 20, 20, 20, 21, 21, 21, 21, 22, 22, 22, 22, 22, 23, 23, 23, 23, 23, 23, 24, 24, 24, 24, 24, 24, 25, 25, 25, 25, 25, 25, 25, 26, 26, 26, 26, 26, 26, 26, 26, 27, 27, 27, 27, 27, 27, 27, 27, 27, 27, 28, 28, 28, 28, 28, 28, 28, 28, 28, 28, 29, 29, 29, 29, 29, 29, 29, 29, 29, 29, 29, 29, 30, 30, 30, 30, 30, 30, 30, 30, 30, 30, 30, 30, 30, 30, 31, 31, 31, 31, 31, 31, 31, 31, 31, 31, 31, 31, 31, 31, 31, 31, 31, 31, 31};

__device__ __forceinline__ int otid() { int t = threadIdx.x; asm volatile("" : "+v"(t)); return t; }
__device__ __forceinline__ float bf2f(unsigned short h) { return __uint_as_float(((unsigned)h) << 16); }
__device__ __forceinline__ unsigned f2bf(float f) { unsigned u = __float_as_uint(f); return (u + 0x7fffu + ((u >> 16) & 1u)) >> 16; }
__device__ __forceinline__ unsigned pk2(float lo, float hi) { return f2bf(lo) | (f2bf(hi) << 16); }
__device__ __forceinline__ float lo16(unsigned v) { return __uint_as_float(v << 16); }
__device__ __forceinline__ float hi16(unsigned v) { return __uint_as_float(v & 0xffff0000u); }
#define UNPACK8(v, f) do { f[0] = lo16((v).x); f[1] = hi16((v).x); f[2] = lo16((v).y); f[3] = hi16((v).y); f[4] = lo16((v).z); f[5] = hi16((v).z); f[6] = lo16((v).w); f[7] = hi16((v).w); } while (0)
__device__ __forceinline__ float sigmoidf_(float x) { return 1.f / (1.f + __expf(-x)); }
__device__ __forceinline__ float siluf_(float x) { return x / (1.f + __expf(-x)); }
__device__ __forceinline__ float softplusf_(float x) { return x > 20.f ? x : log1pf(__expf(x)); }
__device__ __forceinline__ float wave_sum(float v) {
#pragma unroll
    for (int o = 1; o < 64; o <<= 1) v += __shfl_xor(v, o);
    return v;
}
__device__ __forceinline__ float wave_max(float v) {
#pragma unroll
    for (int o = 1; o < 64; o <<= 1) v = fmaxf(v, __shfl_xor(v, o));
    return v;
}
__device__ __forceinline__ void rot_cs(float pos, int i, float& c, float& s) {
    const float ci = __builtin_amdgcn_exp2f(-(float)i * 0.20762050593046014f) * 0.15915494309189535f;
    float rev = pos * ci; rev = rev - floorf(rev);
    s = __builtin_amdgcn_sinf(rev); c = __builtin_amdgcn_cosf(rev);
}

namespace pg8 {
constexpr int BM = 256, BK = 64, HALF = 128, HTB = HALF * BK * 2, STAGE_BYTES = 8 * HTB, NXCD = 8, WGM = 8;
__host__ __device__ __forceinline__ int lds_byte(int r, int c) { const int st = (r >> 4) * 2 + (c >> 5), rr = r & 15, cc = c & 31, ob = rr * 64 + cc * 2; return st * 1024 + (ob ^ (((ob >> 9) & 1) << 5)); }
__host__ __device__ __forceinline__ void stage_rc(int b, int& R, int& C) { const int st = b / 1024, sb = b % 1024, swz = sb ^ (((sb >> 9) & 1) << 5); R = (st >> 1) * 16 + swz / 64; C = (st & 1) * 32 + (swz % 64) / 2; }
__host__ __device__ __forceinline__ int perm32(int rho) { const int n = rho >> 4, i = rho & 15; return 8 * (i >> 2) + 4 * n + (i & 3); }
struct Unit { int pm, pn; };
struct Gemm { const bf16_t* A; const bf16_t* Bt; int M, N, K, lda, ldb; };
struct StaticOrder {
    int nM, nN, nwg, G, c;
    __device__ void init(int M, int N, int G_, int c_) { nM = M / BM; nN = N / BM; nwg = nM * nN; G = G_; c = c_; }
    __device__ bool next(int i, Unit& u) const {
        const long L = (long)i * G + c; if (L >= nwg) return false;
        int wgid = (int)L; { const int q = nwg / NXCD, r = nwg % NXCD, xcd = wgid % NXCD, off = wgid / NXCD; wgid = (xcd < r ? xcd * (q + 1) : r * (q + 1) + (xcd - r) * q) + off; }
        const int nig = WGM * nN, gid = wgid / nig, fm = gid * WGM, gsz = (nM - fm) < WGM ? (nM - fm) : WGM;
        u.pm = fm + ((wgid % nig) % gsz); u.pn = (wgid % nig) / gsz; return true;
    }
};
template <class Epi, bool ALIGN_EPI>
__device__ __forceinline__ void gemm_phase(LAS unsigned char* lds, const Gemm g, const StaticOrder& S, const Epi& E) {
    const int tid = otid(), wid = __builtin_amdgcn_readfirstlane(tid >> 6), lane = tid & 63, wr = wid >> 2, wc = wid & 3, fr = lane & 15, fq = lane >> 4;
    const int K = g.K, nt = K / BK;
    unsigned voffA[2], voffB[2];
#pragma unroll
    for (int i = 0; i < 2; ++i) { int R, C; stage_rc(tid * 16 + i * 8192, R, C); const int Rb = (R & ~31) + perm32(R & 31);
        voffA[i] = (unsigned)(R * g.lda + C) * 2u; voffB[i] = (unsigned)(Rb * g.ldb + C) * 2u; }
    const size_t kstep = (size_t)(BK * 2);
    const size_t hstepA = (size_t)HALF * g.lda * 2, hstepB = (size_t)HALF * g.ldb * 2;
    const size_t tstepA = 2 * hstepA, tstepB = 2 * hstepB;
    const unsigned ldsw = (unsigned)wid * 1024u;
    const int aoff = lds_byte(wr * 64 + fr, fq * 8), boff = lds_byte(wc * 32 + fr, fq * 8);
#define PG8_SA(b, h) (((b) * 2 + (h)) * HTB)
#define PG8_SB(b, h) ((4 + (b) * 2 + (h)) * HTB)
#define PG8_STAGE(bufoff, gbase, voff) do { _Pragma("unroll") for (int _i = 0; _i < 2; ++_i) \
        __builtin_amdgcn_global_load_lds((const unsigned*)((const char*)(gbase) + (voff)[_i]), (LAS unsigned*)(lds + (bufoff) + ldsw + _i * 8192), 16, 0, 0); } while (0)
#define PG8_LDA(dst, b, h) do { _Pragma("unroll") for (int m = 0; m < 4; ++m) _Pragma("unroll") for (int k = 0; k < 2; ++k) dst[m][k] = *(const LAS bf16x8*)(lds + PG8_SA(b, h) + aoff + m * 2048 + k * 1024); } while (0)
#define PG8_LDB(dst, b, h) do { _Pragma("unroll") for (int n = 0; n < 2; ++n) _Pragma("unroll") for (int k = 0; k < 2; ++k) dst[n][k] = *(const LAS bf16x8*)(lds + PG8_SB(b, h) + boff + n * 2048 + k * 1024); } while (0)
#define PG8_MMA(ai, bj, At, Bt) do { __builtin_amdgcn_s_setprio(1); _Pragma("unroll") for (int m = 0; m < 4; ++m) _Pragma("unroll") for (int n = 0; n < 2; ++n) _Pragma("unroll") for (int k = 0; k < 2; ++k) \
        acc[ai][bj][m][n] = __builtin_amdgcn_mfma_f32_16x16x32_bf16(Bt[n][k], At[m][k], acc[ai][bj][m][n], 0, 0, 0); __builtin_amdgcn_s_setprio(0); } while (0)
#define PG8_WAIT_V(n) asm volatile("s_waitcnt vmcnt(" #n ")" ::: "memory")
#define PG8_WAIT_L(n) asm volatile("s_waitcnt lgkmcnt(" #n ")" ::: "memory")
#define PG8_BAR __builtin_amdgcn_s_barrier()
#define PG8_SCHED __builtin_amdgcn_sched_barrier(0)
    Unit cur, nxt; int ui = 0;
    if (!S.next(0, cur)) return;
    f32x4 acc[2][2][4][2];
#pragma unroll
    for (int a = 0; a < 2; ++a)
#pragma unroll
        for (int b = 0; b < 2; ++b)
#pragma unroll
            for (int m = 0; m < 4; ++m)
#pragma unroll
                for (int n = 0; n < 2; ++n) acc[a][b][m][n] = (f32x4){0.f, 0.f, 0.f, 0.f};
    bf16x8 At[4][2], B0[2][2], B1[2][2];
    const char* cA = (const char*)g.A + (size_t)cur.pm * tstepA; const char* cB = (const char*)g.Bt + (size_t)cur.pn * tstepB;
    PG8_STAGE(PG8_SB(0, 0), cB, voffB); PG8_STAGE(PG8_SB(0, 1), cB + hstepB, voffB); PG8_STAGE(PG8_SA(0, 0), cA, voffA); PG8_STAGE(PG8_SA(0, 1), cA + hstepA, voffA);
    if (wr == 1) PG8_BAR;
    PG8_WAIT_V(2); PG8_BAR;
    PG8_STAGE(PG8_SB(1, 0), cB + kstep, voffB); PG8_STAGE(PG8_SA(1, 0), cA + kstep, voffA); PG8_STAGE(PG8_SB(1, 1), cB + hstepB + kstep, voffB);
    PG8_WAIT_V(6); PG8_BAR;
    for (;;) {
        const bool has_next = S.next(ui + 1, nxt);
        const char* nA = has_next ? (const char*)g.A + (size_t)nxt.pm * tstepA : cA; const char* nB = has_next ? (const char*)g.Bt + (size_t)nxt.pn * tstepB : cB;
        for (int t = 0; t < nt; t += 2) {
            const bool last = (t == nt - 2);
            const char* a1 = cA + (size_t)(t + 1) * kstep;
            const char* a2 = last ? nA : cA + (size_t)(t + 2) * kstep; const char* b2 = last ? nB : cB + (size_t)(t + 2) * kstep;
            const char* a3 = a2 + kstep; const char* b3 = b2 + kstep;
            PG8_LDB(B0, 0, 0); PG8_LDB(B1, 0, 1); PG8_SCHED; PG8_LDA(At, 0, 0); PG8_STAGE(PG8_SA(1, 1), a1 + hstepA, voffA);
            PG8_WAIT_V(8); PG8_WAIT_L(0); PG8_BAR; PG8_MMA(0, 0, At, B0); PG8_MMA(0, 1, At, B1); PG8_BAR; PG8_SCHED;
            PG8_LDA(At, 0, 1); PG8_STAGE(PG8_SB(0, 0), b2, voffB); PG8_STAGE(PG8_SB(0, 1), b2 + hstepB, voffB); PG8_STAGE(PG8_SA(0, 0), a2, voffA);
            PG8_WAIT_V(8); PG8_WAIT_L(0); PG8_BAR; PG8_MMA(1, 0, At, B0); PG8_MMA(1, 1, At, B1); PG8_BAR; PG8_SCHED;
            PG8_LDB(B0, 1, 0); PG8_LDB(B1, 1, 1); PG8_SCHED; PG8_LDA(At, 1, 0); PG8_STAGE(PG8_SA(0, 1), a2 + hstepA, voffA);
            PG8_WAIT_V(8); PG8_WAIT_L(0); PG8_BAR; PG8_MMA(0, 0, At, B0); PG8_MMA(0, 1, At, B1); PG8_BAR; PG8_SCHED;
            PG8_LDA(At, 1, 1); PG8_STAGE(PG8_SB(1, 0), b3, voffB); PG8_STAGE(PG8_SB(1, 1), b3 + hstepB, voffB); PG8_STAGE(PG8_SA(1, 0), a3, voffA);
            PG8_WAIT_V(8); PG8_WAIT_L(0); PG8_BAR; PG8_MMA(1, 0, At, B0); PG8_MMA(1, 1, At, B1); PG8_BAR; PG8_SCHED;
        }
        if constexpr (ALIGN_EPI) { if (wr == 0) PG8_BAR; }
        E(acc, cur, wr, wc, fr, fq);
        if (!has_next) break;
#pragma unroll
        for (int a = 0; a < 2; ++a)
#pragma unroll
            for (int b = 0; b < 2; ++b)
#pragma unroll
                for (int m = 0; m < 4; ++m)
#pragma unroll
                    for (int n = 0; n < 2; ++n) acc[a][b][m][n] = (f32x4){0.f, 0.f, 0.f, 0.f};
        cur = nxt; cA = nA; cB = nB; ++ui;
        if constexpr (ALIGN_EPI) { if (wr == 1) PG8_BAR; }
    }
    PG8_WAIT_V(0);
    if constexpr (!ALIGN_EPI) { if (wr == 0) PG8_BAR; }
    PG8_BAR;
#undef PG8_SA
#undef PG8_SB
#undef PG8_STAGE
#undef PG8_LDA
#undef PG8_LDB
#undef PG8_MMA
#undef PG8_WAIT_V
#undef PG8_WAIT_L
#undef PG8_BAR
#undef PG8_SCHED
}
}

struct EpiBf16 {
    bf16_t* O; int ldc;
    __device__ __forceinline__ void operator()(const f32x4 (&acc)[2][2][4][2], const pg8::Unit& u, int wr, int wc, int fr, int fq) const {
        const int row0 = u.pm * 256 + wr * 64 + fr, col0 = u.pn * 256 + wc * 32 + 8 * fq;
#pragma unroll
        for (int ai = 0; ai < 2; ++ai)
#pragma unroll
            for (int m = 0; m < 4; ++m) { bf16_t* rowp = O + (size_t)(row0 + ai * 128 + m * 16) * ldc + col0;
#pragma unroll
                for (int bj = 0; bj < 2; ++bj) { const f32x4 v0 = acc[ai][bj][m][0], v1 = acc[ai][bj][m][1];
                    u32x4 w; w.x = pk2(v0[0], v0[1]); w.y = pk2(v0[2], v0[3]); w.z = pk2(v1[0], v1[1]); w.w = pk2(v1[2], v1[3]);
                    *(u32x4*)(rowp + bj * 128) = w; } }
    }
};
struct EpiGU {
    bf16_t* H;
    __device__ __forceinline__ void operator()(const f32x4 (&acc)[2][2][4][2], const pg8::Unit& u, int wr, int wc, int fr, int fq) const {
        const int row0 = u.pm * 256 + wr * 64 + fr, col0 = u.pn * 256 + wc * 32 + 8 * fq;
#pragma unroll
        for (int ai = 0; ai < 2; ++ai)
#pragma unroll
            for (int m = 0; m < 4; ++m) { bf16_t* rowp = H + (size_t)(row0 + ai * 128 + m * 16) * DFF + (col0 >> 1);
#pragma unroll
                for (int bj = 0; bj < 2; ++bj) { const f32x4 v0 = acc[ai][bj][m][0], v1 = acc[ai][bj][m][1];
                    u32x2 w; w.x = pk2(siluf_(v0[0]) * v1[0], siluf_(v0[1]) * v1[1]); w.y = pk2(siluf_(v0[2]) * v1[2], siluf_(v0[3]) * v1[3]);
                    *(u32x2*)(rowp + bj * 64) = w; } }
    }
};
struct EpiRes {
    const float* X; float* V;
    __device__ __forceinline__ void operator()(const f32x4 (&acc)[2][2][4][2], const pg8::Unit& u, int wr, int wc, int fr, int fq) const {
        const int row0 = u.pm * 256 + wr * 64 + fr, col0 = u.pn * 256 + wc * 32 + 8 * fq;
#pragma unroll
        for (int ai = 0; ai < 2; ++ai)
#pragma unroll
            for (int m = 0; m < 4; ++m) { const size_t off = (size_t)(row0 + ai * 128 + m * 16) * DM + col0;
#pragma unroll
                for (int bj = 0; bj < 2; ++bj) {
                    const f32x4 x0 = *(const f32x4*)(X + off + bj * 128), x1 = *(const f32x4*)(X + off + bj * 128 + 4);
                    *(f32x4*)(V + off + bj * 128) = x0 * ALPHA + acc[ai][bj][m][0]; *(f32x4*)(V + off + bj * 128 + 4) = x1 * ALPHA + acc[ai][bj][m][1]; } }
    }
};
struct EpiBranch {
    const bf16_t* U; const float* RSTD; float* MIX; bf16_t* MIXB; int br;
    __device__ __forceinline__ void operator()(const f32x4 (&acc)[2][2][4][2], const pg8::Unit& u, int wr, int wc, int fr, int fq) const {
        const int row0 = u.pm * 256 + wr * 64 + fr, col0 = u.pn * 256 + wc * 32 + 8 * fq;
        const int gcol = U_GATE + (br == 0 ? 0 : (br == 3 ? 2048 : 1024));
#pragma unroll
        for (int ai = 0; ai < 2; ++ai)
#pragma unroll
            for (int m = 0; m < 4; ++m) { const int row = row0 + ai * 128 + m * 16; const size_t off = (size_t)row * DM + col0;
                float rs = 1.f; if (br == 1) rs = RSTD[row * 2]; else if (br == 2) rs = RSTD[row * 2 + 1];
#pragma unroll
                for (int bj = 0; bj < 2; ++bj) {
                    const u32x4 gv = *(const u32x4*)(U + (size_t)row * NU + gcol + col0 + bj * 128); float gf[8]; UNPACK8(gv, gf);
                    f32x4 v0 = acc[ai][bj][m][0], v1 = acc[ai][bj][m][1];
#pragma unroll
                    for (int e = 0; e < 4; ++e) { v0[e] *= rs * sigmoidf_(gf[e]); v1[e] *= rs * sigmoidf_(gf[4 + e]); }
                    float* mp = MIX + off + bj * 128;
                    if (br != 0) { v0 += *(const f32x4*)mp; v1 += *(const f32x4*)(mp + 4); }
                    if (br != 3) { *(f32x4*)mp = v0; *(f32x4*)(mp + 4) = v1; }
                    else { u32x4 w; w.x = pk2(v0[0], v0[1]); w.y = pk2(v0[2], v0[3]); w.z = pk2(v1[0], v1[1]); w.w = pk2(v1[2], v1[3]); *(u32x4*)(MIXB + off + bj * 128) = w; } } }
    }
};

struct Args { const float* in[27]; float* out; unsigned char* ws; int ph_lo, ph_hi; };
struct Ctx {
    const float* const* in; float* out; unsigned char* ws;
    bf16_t *XB, *U, *ABR, *MIXB, *H; float *XF, *MIX, *KV, *ST, *CSL, *RSTD;
    int l;
};

template <int NB, int KS>
__device__ __forceinline__ void mm_strip(f32x4 (&acc)[NB], const LAS unsigned char* A, int lda_b, const LAS unsigned char* Bt, int ldb_b, int fr, int fq) {
#pragma unroll
    for (int ks = 0; ks < KS; ++ks) {
        const bf16x8 a = *(const LAS bf16x8*)(A + fr * lda_b + ks * 64 + fq * 16);
#pragma unroll
        for (int nb = 0; nb < NB; ++nb) {
            const bf16x8 b = *(const LAS bf16x8*)(Bt + (nb * 16 + fr) * ldb_b + ks * 64 + fq * 16);
            acc[nb] = __builtin_amdgcn_mfma_f32_16x16x32_bf16(b, a, acc[nb], 0, 0, 0);
        }
    }
}

__device__ __forceinline__ int dest_row(int mode, int n) {
    if (mode == 1) return n < 4608 ? n : (n < 4624 ? 8448 + (n - 4608) : n - 16);
    if (mode == 2) return 8 * (n >> 2) + (n & 3);
    if (mode == 3) return 8 * (n >> 2) + 4 + (n & 3);
    return n;
}
__device__ __forceinline__ void transpose_item(const float* W, int K, int N, bf16_t* WT, int ldk, int koff, int mode, const float* kscale, LAS float* scr, int item, int lane) {
    const int nblk = (N + 31) / 32, kb = item / nblk, nb = item % nblk, k0 = 64 * kb, n0 = 32 * nb;
    const int nn = n0 + (lane & 31);
#pragma unroll 8
    for (int i = 0; i < 32; ++i) { const int kk = 2 * i + (lane >> 5); float v = 0.f; if (nn < N) { v = W[(size_t)(k0 + kk) * N + nn]; if (kscale) v *= kscale[k0 + kk]; } scr[kk * 33 + (lane & 31)] = v; }
    asm volatile("s_waitcnt lgkmcnt(0)" ::: "memory");
    const int c = lane & 7;
#pragma unroll
    for (int j = 0; j < 4; ++j) { const int n = (lane >> 3) + 8 * j; const LAS float* s = scr + (8 * c) * 33 + n;
        u32x4 o; o.x = pk2(s[0 * 33], s[1 * 33]); o.y = pk2(s[2 * 33], s[3 * 33]); o.z = pk2(s[4 * 33], s[5 * 33]); o.w = pk2(s[6 * 33], s[7 * 33]);
        if (n0 + n < N) *(u32x4*)(WT + (size_t)dest_row(mode, n0 + n) * ldk + koff + k0 + 8 * c) = o; }
    asm volatile("s_waitcnt lgkmcnt(0)" ::: "memory");
}
__device__ __forceinline__ bf16_t* wl(unsigned char* ws, int l, size_t off) { return (bf16_t*)(ws + WS_W + (size_t)l * SZ_WL + off); }
constexpr size_t OFF_WIN = 0, OFF_WBR = SZ_WIN, OFF_WOUT = OFF_WBR + SZ_WBR, OFF_WGU = OFF_WOUT + SZ_WOUT, OFF_WDN = OFF_WGU + SZ_WGU;

__device__ __forceinline__ void prologue(const Ctx& c, LAS unsigned char* lds) {
    const int tid = otid(), wave = tid >> 6, lane = tid & 63;
    const int G = gridDim.x, gw = blockIdx.x * 8 + wave, NGW = G * 8;
    LAS float* scr = (LAS float*)(lds + wave * 16384);
    constexpr int I_IN = 16 * 265, I_R = 8 * 32, I_S = 16 * 32, I_O = 16 * 32, I_G = 16 * 88, I_D = 44 * 32;
    constexpr int I_LAYER = I_IN + I_R + I_S + I_R + I_O + I_G + I_G + I_D;
    for (int it = gw; it < NLAYER * I_LAYER; it += NGW) {
        const int l = it / I_LAYER; int r = it % I_LAYER;
        if (r < I_IN) { transpose_item(c.in[7] + (size_t)l * DM * NIN, DM, NIN, wl(c.ws, l, OFF_WIN), DM, 0, 1, nullptr, scr, r, lane); continue; } r -= I_IN;
        if (r < I_R) { transpose_item(c.in[16] + (size_t)l * 512 * DM, 512, DM, wl(c.ws, l, OFF_WBR), KBR, 0, 0, nullptr, scr, r, lane); continue; } r -= I_R;
        if (r < I_S) { transpose_item(c.in[17] + (size_t)l * 1024 * DM, 1024, DM, wl(c.ws, l, OFF_WBR), KBR, 512, 0, c.in[13] + l * 1024, scr, r, lane); continue; } r -= I_S;
        if (r < I_R) { transpose_item(c.in[18] + (size_t)l * 512 * DM, 512, DM, wl(c.ws, l, OFF_WBR), KBR, 1536, 0, nullptr, scr, r, lane); continue; } r -= I_R;
        if (r < I_O) { transpose_item(c.in[19] + (size_t)l * DM * DM, DM, DM, wl(c.ws, l, OFF_WOUT), DM, 0, 0, nullptr, scr, r, lane); continue; } r -= I_O;
        if (r < I_G) { transpose_item(c.in[24] + (size_t)l * DM * DFF, DM, DFF, wl(c.ws, l, OFF_WGU), DM, 0, 2, nullptr, scr, r, lane); continue; } r -= I_G;
        if (r < I_G) { transpose_item(c.in[25] + (size_t)l * DM * DFF, DM, DFF, wl(c.ws, l, OFF_WGU), DM, 0, 3, nullptr, scr, r, lane); continue; } r -= I_G;
        transpose_item(c.in[26] + (size_t)l * DFF * DM, DFF, DM, wl(c.ws, l, OFF_WDN), DFF, 0, 0, nullptr, scr, r, lane);
    }
    const int gt = blockIdx.x * 512 + tid, NT = G * 512;
    for (int i = gt; i < NLAYER * 240 * 128; i += NT) { const int l = i / (240 * 128), r = i % (240 * 128); *(u32x4*)(wl(c.ws, l, OFF_WIN) + (size_t)(NIN + r / 128) * DM + (r % 128) * 8) = (u32x4){0u, 0u, 0u, 0u}; }
    for (int i = gt; i < MP * (DM / 4); i += NT) { const int row = i >> 8, c4 = (i & 255) * 4;
        f32x4 v = (f32x4){0.f, 0.f, 0.f, 0.f};
        if (row < MPR) v = *(const f32x4*)(c.in[0] + (size_t)row * DM + c4); else if (row < MREAL) v = *(const f32x4*)(c.in[1] + (size_t)(row - MPR) * DM + c4);
        *(f32x4*)(c.XF + (size_t)row * DM + c4) = v; u32x2 w; w.x = pk2(v[0], v[1]); w.y = pk2(v[2], v[3]); *(u32x2*)(c.XB + (size_t)row * DM + c4) = w; }
}

__device__ __forceinline__ void ln_phase(const Ctx& c, const float* g, const float* b, bool final_out) {
    const int tid = otid(), wave = tid >> 6, lane = tid & 63;
    const int gw = blockIdx.x * 8 + wave, NGW = gridDim.x * 8;
    for (int row = gw; row < MREAL; row += NGW) {
        const f32x4* xr = (const f32x4*)(c.MIX + (size_t)row * DM) + lane;
        f32x4 v[4]; float s = 0.f;
#pragma unroll
        for (int j = 0; j < 4; ++j) { v[j] = xr[64 * j]; s += (v[j][0] + v[j][1]) + (v[j][2] + v[j][3]); }
        const float mean = wave_sum(s) * (1.f / DM); float s2 = 0.f;
#pragma unroll
        for (int j = 0; j < 4; ++j) { v[j] = v[j] - mean; s2 += (v[j][0] * v[j][0] + v[j][1] * v[j][1]) + (v[j][2] * v[j][2] + v[j][3] * v[j][3]); }
        const float rstd = rsqrtf(wave_sum(s2) * (1.f / DM) + EPS);
#pragma unroll
        for (int j = 0; j < 4; ++j) { const int col = (lane + 64 * j) * 4; const f32x4 gg = *(const f32x4*)(g + col), bb = *(const f32x4*)(b + col);
            const f32x4 o = v[j] * rstd * gg + bb;
            if (final_out) *(f32x4*)(c.out + O_Y + (size_t)row * DM + col) = o;
            else { *(f32x4*)(c.XF + (size_t)row * DM + col) = o; u32x2 w; w.x = pk2(o[0], o[1]); w.y = pk2(o[2], o[3]); *(u32x2*)(c.XB + (size_t)row * DM + col) = w; } }
    }
}

__device__ __forceinline__ void conv8(const Ctx& c, int row, int t, int cb, float (&o)[8]) {
    const float* cw = c.in[8] + (size_t)c.l * 4 * 1536 + cb; const float* cbias = c.in[9] + (size_t)c.l * 1536 + cb;
    { const f32x4 b0 = *(const f32x4*)cbias, b1 = *(const f32x4*)(cbias + 4); o[0] = b0[0]; o[1] = b0[1]; o[2] = b0[2]; o[3] = b0[3]; o[4] = b1[0]; o[5] = b1[1]; o[6] = b1[2]; o[7] = b1[3]; }
#pragma unroll
    for (int tau = 0; tau < 4; ++tau) {
        const int dt = tau - 3;
        if (t + dt >= 0) {
            const u32x4 xv = *(const u32x4*)(c.U + (size_t)(row + dt) * NU + U_XBC + cb); float xf[8]; UNPACK8(xv, xf);
            const f32x4 w0 = *(const f32x4*)(cw + tau * 1536), w1 = *(const f32x4*)(cw + tau * 1536 + 4);
            o[0] += w0[0] * xf[0]; o[1] += w0[1] * xf[1]; o[2] += w0[2] * xf[2]; o[3] += w0[3] * xf[3]; o[4] += w1[0] * xf[4]; o[5] += w1[1] * xf[5]; o[6] += w1[2] * xf[6]; o[7] += w1[3] * xf[7];
        }
    }
#pragma unroll
    for (int e = 0; e < 8; ++e) o[e] = siluf_(o[e]);
}
__device__ __forceinline__ void ssd_dtcs(const Ctx& c, int row0, int g, LAS float* dtS, LAS float* csS, int w, int lane, float* csl_out) {
    const int h = g * 8 + w;
    const float bias = c.in[10][c.l * 16 + h], a = -__expf(c.in[11][c.l * 16 + h]);
    const int j = 2 * lane;
    const float d0 = softplusf_(bf2f(c.U[(size_t)(row0 + j) * NU + U_DT + h]) + bias), d1 = softplusf_(bf2f(c.U[(size_t)(row0 + j + 1) * NU + U_DT + h]) + bias);
    const float v0 = d0 * a, v1 = d1 * a; float s = v0 + v1;
#pragma unroll
    for (int o = 1; o < 64; o <<= 1) { const float t = __shfl_up(s, o); if (lane >= o) s += t; }
    const float ex = s - (v0 + v1);
    dtS[w * 128 + j] = d0; dtS[w * 128 + j + 1] = d1; csS[w * 128 + j] = ex + v0; csS[w * 128 + j + 1] = s;
    if (csl_out && lane == 63) *csl_out = s;
}

constexpr int LD136 = 272;

__device__ __forceinline__ void ret1_tile(const Ctx& c, int item, LAS unsigned char* lds) {
    const int tid = otid(), w = tid >> 6, lane = tid & 63, fr = lane & 15, fq = lane >> 4;
    const int n = item & 15, h = (item >> 4) & 3, b = item >> 6;
    const int row0 = b * PL + n * 128;
    const float lg = __logf(1.f - exp2f(-5.f - (float)h));
    LAS bf16_t* Kt = (LAS bf16_t*)lds; LAS bf16_t* Vt = Kt + 128 * 136;
#pragma unroll
    for (int r = 0; r < 2; ++r) { const int unit = tid + 512 * r, dg = unit & 7, j = unit >> 3;
        const bf16_t* src = c.U + (size_t)(row0 + j) * NU + U_KR + h * 128 + dg * 8;
        const u32x4 lo = *(const u32x4*)src, hi = *(const u32x4*)(src + 64); float fl[8], fh[8]; UNPACK8(lo, fl); UNPACK8(hi, fh);
        const float pos = (float)(n * 128 + j), sc = 0.08838834764831845f * __expf(lg * (float)(127 - j));
#pragma unroll
        for (int e = 0; e < 8; ++e) { float cs, sn; rot_cs(pos, dg * 8 + e, cs, sn);
            Kt[(dg * 8 + e) * 136 + j] = (bf16_t)f2bf((fl[e] * cs - fh[e] * sn) * sc); Kt[(64 + dg * 8 + e) * 136 + j] = (bf16_t)f2bf((fl[e] * sn + fh[e] * cs) * sc); } }
#pragma unroll
    for (int r = 0; r < 4; ++r) { const int unit = tid + 512 * r, vg = unit & 15, j = unit >> 4;
        const u32x4 vv = *(const u32x4*)(c.U + (size_t)(row0 + j) * NU + U_VR + h * 128 + vg * 8);
        const unsigned q[4] = {vv.x, vv.y, vv.z, vv.w};
#pragma unroll
        for (int e = 0; e < 4; ++e) { Vt[(vg * 8 + 2 * e) * 136 + j] = (bf16_t)(q[e] & 0xffffu); Vt[(vg * 8 + 2 * e + 1) * 136 + j] = (bf16_t)(q[e] >> 16); } }
    __syncthreads();
    f32x4 acc[8];
#pragma unroll
    for (int i = 0; i < 8; ++i) acc[i] = (f32x4){0.f, 0.f, 0.f, 0.f};
    mm_strip<8, 4>(acc, (const LAS unsigned char*)Kt + w * 16 * LD136, LD136, (const LAS unsigned char*)Vt, LD136, fr, fq);
    float* dst = c.KV + ((size_t)((b * 4 + h) * 16 + n)) * 16384 + (16 * w + fr) * 128 + 4 * fq;
#pragma unroll
    for (int nb = 0; nb < 8; ++nb) *(f32x4*)(dst + 16 * nb) = acc[nb];
    __syncthreads();
}

__device__ __forceinline__ void ret2_tile(const Ctx& c, int item, LAS unsigned char* lds) {
    const int tid = otid(), w = tid >> 6, lane = tid & 63, fr = lane & 15, fq = lane >> 4;
    const int n = item & 15, h = (item >> 4) & 3, b = item >> 6;
    const int row0 = b * PL + n * 128;
    const float lg = __logf(1.f - exp2f(-5.f - (float)h));
    LAS bf16_t* Qs = (LAS bf16_t*)lds; LAS bf16_t* Ks = Qs + 128 * 136; LAS bf16_t* Vt = Ks + 128 * 136; LAS bf16_t* St = Vt + 128 * 136;
#pragma unroll
    for (int r = 0; r < 2; ++r) { const int unit = tid + 512 * r, dg = unit & 7, j = unit >> 3;
        const bf16_t* qsrc = c.U + (size_t)(row0 + j) * NU + U_QR + h * 128 + dg * 8; const bf16_t* ksrc = qsrc + (U_KR - U_QR);
        const u32x4 qlo = *(const u32x4*)qsrc, qhi = *(const u32x4*)(qsrc + 64), klo = *(const u32x4*)ksrc, khi = *(const u32x4*)(ksrc + 64);
        float ql[8], qh[8], kl[8], kh[8]; UNPACK8(qlo, ql); UNPACK8(qhi, qh); UNPACK8(klo, kl); UNPACK8(khi, kh);
        const float pos = (float)(n * 128 + j); float q1[8], q2[8], k1[8], k2[8];
#pragma unroll
        for (int e = 0; e < 8; ++e) { float cs, sn; rot_cs(pos, dg * 8 + e, cs, sn);
            q1[e] = ql[e] * cs - qh[e] * sn; q2[e] = ql[e] * sn + qh[e] * cs;
            k1[e] = (kl[e] * cs - kh[e] * sn) * 0.08838834764831845f; k2[e] = (kl[e] * sn + kh[e] * cs) * 0.08838834764831845f; }
        u32x4 o;
        o.x = pk2(q1[0], q1[1]); o.y = pk2(q1[2], q1[3]); o.z = pk2(q1[4], q1[5]); o.w = pk2(q1[6], q1[7]); *(LAS u32x4*)(Qs + j * 136 + dg * 8) = o;
        o.x = pk2(q2[0], q2[1]); o.y = pk2(q2[2], q2[3]); o.z = pk2(q2[4], q2[5]); o.w = pk2(q2[6], q2[7]); *(LAS u32x4*)(Qs + j * 136 + 64 + dg * 8) = o;
        o.x = pk2(k1[0], k1[1]); o.y = pk2(k1[2], k1[3]); o.z = pk2(k1[4], k1[5]); o.w = pk2(k1[6], k1[7]); *(LAS u32x4*)(Ks + j * 136 + dg * 8) = o;
        o.x = pk2(k2[0], k2[1]); o.y = pk2(k2[2], k2[3]); o.z = pk2(k2[4], k2[5]); o.w = pk2(k2[6], k2[7]); *(LAS u32x4*)(Ks + j * 136 + 64 + dg * 8) = o; }
#pragma unroll
    for (int r = 0; r < 4; ++r) { const int unit = tid + 512 * r, vg = unit & 15, j = unit >> 4;
        const u32x4 vv = *(const u32x4*)(c.U + (size_t)(row0 + j) * NU + U_VR + h * 128 + vg * 8);
        const unsigned q[4] = {vv.x, vv.y, vv.z, vv.w};
#pragma unroll
        for (int e = 0; e < 4; ++e) { Vt[(vg * 8 + 2 * e) * 136 + j] = (bf16_t)(q[e] & 0xffffu); Vt[(vg * 8 + 2 * e + 1) * 136 + j] = (bf16_t)(q[e] >> 16); } }
    { const float* sb = c.KV + ((size_t)((b * 4 + h) * 16 + n)) * 16384;
#pragma unroll
      for (int r = 0; r < 8; ++r) { const int unit = tid + 512 * r, vq = unit & 31, d = unit >> 5;
          const f32x4 sv = *(const f32x4*)(sb + d * 128 + vq * 4);
#pragma unroll
          for (int e = 0; e < 4; ++e) St[(vq * 4 + e) * 136 + d] = (bf16_t)f2bf(sv[e]); } }
    __syncthreads();
    f32x4 acc[8];
#pragma unroll
    for (int i = 0; i < 8; ++i) acc[i] = (f32x4){0.f, 0.f, 0.f, 0.f};
    mm_strip<8, 4>(acc, (const LAS unsigned char*)Qs + w * 16 * LD136, LD136, (const LAS unsigned char*)Ks, LD136, fr, fq);
    const int i = 16 * w + fr;
    __syncthreads();
#pragma unroll
    for (int nb = 0; nb < 8; ++nb) { float p[4];
#pragma unroll
        for (int e = 0; e < 4; ++e) { const int dl = i - (16 * nb + 4 * fq + e); p[e] = dl >= 0 ? acc[nb][e] * __expf(lg * (float)dl) : 0.f; }
        u32x2 o; o.x = pk2(p[0], p[1]); o.y = pk2(p[2], p[3]); *(LAS u32x2*)(Ks + i * 136 + 16 * nb + 4 * fq) = o; }
    f32x4 a2[8], a3[8];
#pragma unroll
    for (int k = 0; k < 8; ++k) { a2[k] = (f32x4){0.f, 0.f, 0.f, 0.f}; a3[k] = (f32x4){0.f, 0.f, 0.f, 0.f}; }
    mm_strip<8, 4>(a2, (const LAS unsigned char*)Ks + w * 16 * LD136, LD136, (const LAS unsigned char*)Vt, LD136, fr, fq);
    mm_strip<8, 4>(a3, (const LAS unsigned char*)Qs + w * 16 * LD136, LD136, (const LAS unsigned char*)St, LD136, fr, fq);
    const float qd = __expf(lg * (float)(i + 1)); float s = 0.f;
#pragma unroll
    for (int nb = 0; nb < 8; ++nb) { a2[nb] = a2[nb] + a3[nb] * qd; s += (a2[nb][0] + a2[nb][1]) + (a2[nb][2] + a2[nb][3]); }
    s += __shfl_xor(s, 16); s += __shfl_xor(s, 32);
    const float mean = s * (1.f / 128.f); float q = 0.f;
#pragma unroll
    for (int nb = 0; nb < 8; ++nb) { a2[nb] = a2[nb] - mean; q += (a2[nb][0] * a2[nb][0] + a2[nb][1] * a2[nb][1]) + (a2[nb][2] * a2[nb][2] + a2[nb][3] * a2[nb][3]); }
    q += __shfl_xor(q, 16); q += __shfl_xor(q, 32);
    const float rstd = rsqrtf(q * (1.f / 128.f) + EPS);
    const bf16_t* gp = c.U + (size_t)(row0 + i) * NU + U_GR + h * 128 + 4 * fq; bf16_t* op = c.ABR + (size_t)(row0 + i) * KBR + h * 128 + 4 * fq;
#pragma unroll
    for (int nb = 0; nb < 8; ++nb) { const u32x2 gv = *(const u32x2*)(gp + 16 * nb);
        const float g0 = siluf_(lo16(gv.x)), g1 = siluf_(hi16(gv.x)), g2 = siluf_(lo16(gv.y)), g3 = siluf_(hi16(gv.y));
        u32x2 o; o.x = pk2(a2[nb][0] * rstd * g0, a2[nb][1] * rstd * g1); o.y = pk2(a2[nb][2] * rstd * g2, a2[nb][3] * rstd * g3); *(u32x2*)(op + 16 * nb) = o; }
    __syncthreads();
}

__device__ __forceinline__ void ssd1_tile(const Ctx& c, int item, LAS unsigned char* lds) {
    const int tid = otid(), w = tid >> 6, lane = tid & 63, fr = lane & 15, fq = lane >> 4;
    const int g = item & 1, n = (item >> 1) & 15, b = item >> 5;
    const int row0 = b * PL + n * 128;
    LAS bf16_t* Bt = (LAS bf16_t*)lds; LAS bf16_t* Xt = Bt + 128 * 136; LAS float* dtS = (LAS float*)(Xt + 64 * 136); LAS float* csS = dtS + 1024;
    ssd_dtcs(c, row0, g, dtS, csS, w, lane, c.CSL + (b * 16 + n) * 16 + g * 8 + w);
#pragma unroll
    for (int r = 0; r < 4; ++r) { const int unit = tid + 512 * r, sg = unit & 15, j = unit >> 4; float o[8];
        conv8(c, row0 + j, n * 128 + j, 1024 + g * 128 + sg * 8, o);
#pragma unroll
        for (int e = 0; e < 8; ++e) Bt[(sg * 8 + e) * 136 + j] = (bf16_t)f2bf(o[e]); }
    __syncthreads();
    for (int hl = 0; hl < 8; ++hl) { const int h = g * 8 + hl;
        const float csl = csS[hl * 128 + 127];
#pragma unroll
        for (int r = 0; r < 2; ++r) { const int unit = tid + 512 * r, pg = unit & 7, j = unit >> 3; float o[8];
            conv8(c, row0 + j, n * 128 + j, h * 64 + pg * 8, o);
            const float sc = dtS[hl * 128 + j] * __expf(csl - csS[hl * 128 + j]);
#pragma unroll
            for (int e = 0; e < 8; ++e) Xt[(pg * 8 + e) * 136 + j] = (bf16_t)f2bf(o[e] * sc); }
        __syncthreads();
        const int strip = w & 3, nh = w >> 2;
        f32x4 acc[4];
#pragma unroll
        for (int k = 0; k < 4; ++k) acc[k] = (f32x4){0.f, 0.f, 0.f, 0.f};
        mm_strip<4, 4>(acc, (const LAS unsigned char*)Xt + strip * 16 * LD136, LD136, (const LAS unsigned char*)Bt + nh * 64 * LD136, LD136, fr, fq);
        float* dst = c.ST + ((size_t)(((b * 16 + n) * 16 + h) * 64 + 16 * strip + fr)) * 128 + nh * 64 + 4 * fq;
#pragma unroll
        for (int nb = 0; nb < 4; ++nb) *(f32x4*)(dst + 16 * nb) = acc[nb];
        __syncthreads();
    }
}

__device__ __forceinline__ void ssd2_tile(const Ctx& c, int item, LAS unsigned char* lds) {
    const int tid = otid(), w = tid >> 6, lane = tid & 63, fr = lane & 15, fq = lane >> 4;
    const int g = item & 1, n = (item >> 1) & 15, b = item >> 5;
    const int row0 = b * PL + n * 128;
    LAS bf16_t* Cs = (LAS bf16_t*)lds; LAS bf16_t* Bs = Cs + 128 * 136; LAS bf16_t* Xt = Bs + 128 * 136; LAS bf16_t* Ss = Xt + 64 * 136;
    LAS float* dtS = (LAS float*)(Ss + 64 * 136); LAS float* csS = dtS + 1024;
    ssd_dtcs(c, row0, g, dtS, csS, w, lane, nullptr);
#pragma unroll
    for (int r = 0; r < 4; ++r) { const int unit = tid + 512 * r, sg = unit & 15, j = unit >> 4; float o[8]; u32x4 pk;
        conv8(c, row0 + j, n * 128 + j, 1024 + g * 128 + sg * 8, o);
        pk.x = pk2(o[0], o[1]); pk.y = pk2(o[2], o[3]); pk.z = pk2(o[4], o[5]); pk.w = pk2(o[6], o[7]); *(LAS u32x4*)(Bs + j * 136 + sg * 8) = pk;
        conv8(c, row0 + j, n * 128 + j, 1280 + g * 128 + sg * 8, o);
        pk.x = pk2(o[0], o[1]); pk.y = pk2(o[2], o[3]); pk.z = pk2(o[4], o[5]); pk.w = pk2(o[6], o[7]); *(LAS u32x4*)(Cs + j * 136 + sg * 8) = pk; }
    __syncthreads();
    f32x4 cb[8];
#pragma unroll
    for (int k = 0; k < 8; ++k) cb[k] = (f32x4){0.f, 0.f, 0.f, 0.f};
    mm_strip<8, 4>(cb, (const LAS unsigned char*)Cs + w * 16 * LD136, LD136, (const LAS unsigned char*)Bs, LD136, fr, fq);
    __syncthreads();
    const int i = 16 * w + fr; float sumsq = 0.f;
    for (int hl = 0; hl < 8; ++hl) { const int h = g * 8 + hl;
#pragma unroll
        for (int r = 0; r < 2; ++r) { const int unit = tid + 512 * r, pg = unit & 7, j = unit >> 3; float o[8];
            conv8(c, row0 + j, n * 128 + j, h * 64 + pg * 8, o);
#pragma unroll
            for (int e = 0; e < 8; ++e) Xt[(pg * 8 + e) * 136 + j] = (bf16_t)f2bf(o[e]); }
        { const float* sb = c.ST + ((size_t)(((b * 16 + n) * 16 + h) * 64)) * 128;
#pragma unroll
          for (int r = 0; r < 2; ++r) { const int unit = tid + 512 * r, s8 = unit & 15, p = unit >> 4;
              const f32x4 v0 = *(const f32x4*)(sb + p * 128 + s8 * 8), v1 = *(const f32x4*)(sb + p * 128 + s8 * 8 + 4);
              u32x4 pk; pk.x = pk2(v0[0], v0[1]); pk.y = pk2(v0[2], v0[3]); pk.z = pk2(v1[0], v1[1]); pk.w = pk2(v1[2], v1[3]); *(LAS u32x4*)(Ss + p * 136 + s8 * 8) = pk; } }
        const float csi = csS[hl * 128 + i];
#pragma unroll
        for (int nb = 0; nb < 8; ++nb) { const f32x4 csj = *(const LAS f32x4*)(csS + hl * 128 + 16 * nb + 4 * fq), dtj = *(const LAS f32x4*)(dtS + hl * 128 + 16 * nb + 4 * fq); float p[4];
#pragma unroll
            for (int e = 0; e < 4; ++e) { const int j = 16 * nb + 4 * fq + e; p[e] = (i >= j) ? cb[nb][e] * __expf(csi - csj[e]) * dtj[e] : 0.f; }
            u32x2 o; o.x = pk2(p[0], p[1]); o.y = pk2(p[2], p[3]); *(LAS u32x2*)(Bs + i * 136 + 16 * nb + 4 * fq) = o; }
        __syncthreads();
        f32x4 yi[4], yc[4];
#pragma unroll
        for (int k = 0; k < 4; ++k) { yi[k] = (f32x4){0.f, 0.f, 0.f, 0.f}; yc[k] = (f32x4){0.f, 0.f, 0.f, 0.f}; }
        mm_strip<4, 4>(yi, (const LAS unsigned char*)Bs + w * 16 * LD136, LD136, (const LAS unsigned char*)Xt, LD136, fr, fq);
        mm_strip<4, 4>(yc, (const LAS unsigned char*)Cs + w * 16 * LD136, LD136, (const LAS unsigned char*)Ss, LD136, fr, fq);
        const float ecs = __expf(csi), dsk = c.in[12][c.l * 16 + h];
        const bf16_t* zp = c.U + (size_t)(row0 + i) * NU + U_Z + h * 64 + 4 * fq; bf16_t* op = c.ABR + (size_t)(row0 + i) * KBR + 512 + h * 64 + 4 * fq;
#pragma unroll
        for (int nb = 0; nb < 4; ++nb) { const u32x2 zv = *(const u32x2*)(zp + 16 * nb); const float zz[4] = {lo16(zv.x), hi16(zv.x), lo16(zv.y), hi16(zv.y)}; float y[4];
#pragma unroll
            for (int e = 0; e < 4; ++e) { const float xv = bf2f(Xt[(16 * nb + 4 * fq + e) * 136 + i]); y[e] = (yi[nb][e] + ecs * yc[nb][e] + dsk * xv) * siluf_(zz[e]); sumsq += y[e] * y[e]; }
            u32x2 o; o.x = pk2(y[0], y[1]); o.y = pk2(y[2], y[3]); *(u32x2*)(op + 16 * nb) = o; }
        __syncthreads();
    }
    sumsq += __shfl_xor(sumsq, 16); sumsq += __shfl_xor(sumsq, 32);
    if (fq == 0) c.RSTD[(row0 + i) * 2 + g] = rsqrtf(sumsq * (1.f / 512.f) + EPS);
}

__device__ __forceinline__ void swa_tile(const Ctx& c, int item, LAS unsigned char* lds) {
    const int tid = otid(), w = tid >> 6, lane = tid & 63, fr = lane & 15, fq = lane >> 4;
    const int kvh = item & 1, qb = (item >> 1) & 15, b = item >> 5;
    const int row0 = b * PL + qb * 128;
    LAS bf16_t* Ks = (LAS bf16_t*)lds; LAS bf16_t* Vt = Ks + 256 * 72; LAS bf16_t* Ps = Vt + 64 * 264; LAS float* biasT = (LAS float*)(Ps + 128 * 168);
#pragma unroll
    for (int r = 0; r < 4; ++r) { const int unit = tid + 512 * r, dg = unit & 7, jx = unit >> 3; const int kp = qb * 128 - 128 + jx;
        u32x4 kv = (u32x4){0u, 0u, 0u, 0u}, vv = (u32x4){0u, 0u, 0u, 0u};
        if (kp >= 0) { const bf16_t* src = c.U + (size_t)(b * PL + kp) * NU + U_KC + kvh * 64 + dg * 8; kv = *(const u32x4*)src; vv = *(const u32x4*)(src + (U_VC - U_KC)); }
        *(LAS u32x4*)(Ks + jx * 72 + dg * 8) = kv;
        const unsigned q[4] = {vv.x, vv.y, vv.z, vv.w};
#pragma unroll
        for (int e = 0; e < 4; ++e) { Vt[(dg * 8 + 2 * e) * 264 + jx] = (bf16_t)(q[e] & 0xffffu); Vt[(dg * 8 + 2 * e + 1) * 264 + jx] = (bf16_t)(q[e] >> 16); } }
    for (int idx = tid; idx < 4 * 129; idx += 512) { const int gq = idx / 129, d = idx % 129; biasT[gq * 132 + d] = c.in[15][T5_BUCKET[d] * 8 + kvh * 4 + gq]; }
    __syncthreads();
    const int jstart = (16 * w < 96) ? 16 * w : 96;
    const int i = 16 * w + fr;
    for (int gq = 0; gq < 4; ++gq) { const int hq = kvh * 4 + gq;
        const bf16_t* qrow = c.U + (size_t)(row0 + i) * NU + U_QC + hq * 64;
        const bf16x8 qa0 = *(const bf16x8*)(qrow + fq * 8), qa1 = *(const bf16x8*)(qrow + 32 + fq * 8);
        f32x4 acc[10];
#pragma unroll
        for (int nb = 0; nb < 10; ++nb) { acc[nb] = (f32x4){0.f, 0.f, 0.f, 0.f};
            const LAS bf16_t* kr = Ks + (jstart + 16 * nb + fr) * 72 + fq * 8;
            acc[nb] = __builtin_amdgcn_mfma_f32_16x16x32_bf16(*(const LAS bf16x8*)kr, qa0, acc[nb], 0, 0, 0);
            acc[nb] = __builtin_amdgcn_mfma_f32_16x16x32_bf16(*(const LAS bf16x8*)(kr + 32), qa1, acc[nb], 0, 0, 0); }
        const float sink = c.in[14][c.l * 8 + hq]; float m = sink;
#pragma unroll
        for (int nb = 0; nb < 10; ++nb)
#pragma unroll
            for (int e = 0; e < 4; ++e) { const int jx = jstart + 16 * nb + 4 * fq + e, dist = i + 128 - jx; const bool ok = dist >= 0 && dist <= 128 && (qb > 0 || jx >= 128);
                const int dc = dist < 0 ? 0 : (dist > 128 ? 128 : dist);
                const float lgt = ok ? acc[nb][e] * 0.125f + biasT[gq * 132 + dc] : -1e30f; acc[nb][e] = lgt; m = fmaxf(m, lgt); }
        m = fmaxf(m, __shfl_xor(m, 16)); m = fmaxf(m, __shfl_xor(m, 32));
        float s = 0.f;
#pragma unroll
        for (int nb = 0; nb < 10; ++nb)
#pragma unroll
            for (int e = 0; e < 4; ++e) { const float p = acc[nb][e] > -1e29f ? __expf(acc[nb][e] - m) : 0.f; acc[nb][e] = p; s += p; }
        s += __shfl_xor(s, 16); s += __shfl_xor(s, 32);
        const float inv = 1.f / (s + __expf(sink - m));
#pragma unroll
        for (int nb = 0; nb < 10; ++nb) { u32x2 o; o.x = pk2(acc[nb][0] * inv, acc[nb][1] * inv); o.y = pk2(acc[nb][2] * inv, acc[nb][3] * inv); *(LAS u32x2*)(Ps + i * 168 + 16 * nb + 4 * fq) = o; }
        f32x4 oa[4];
#pragma unroll
        for (int k = 0; k < 4; ++k) oa[k] = (f32x4){0.f, 0.f, 0.f, 0.f};
#pragma unroll
        for (int ks = 0; ks < 5; ++ks) { const bf16x8 a = *(const LAS bf16x8*)(Ps + i * 168 + ks * 32 + fq * 8);
#pragma unroll
            for (int nb = 0; nb < 4; ++nb) { const bf16x8 bb = *(const LAS bf16x8*)(Vt + (16 * nb + fr) * 264 + jstart + ks * 32 + fq * 8); oa[nb] = __builtin_amdgcn_mfma_f32_16x16x32_bf16(bb, a, oa[nb], 0, 0, 0); } }
        bf16_t* op = c.ABR + (size_t)(row0 + i) * KBR + 1536 + hq * 64 + 4 * fq;
#pragma unroll
        for (int nb = 0; nb < 4; ++nb) { u32x2 o; o.x = pk2(oa[nb][0], oa[nb][1]); o.y = pk2(oa[nb][2], oa[nb][3]); *(u32x2*)(op + 16 * nb) = o; }
    }
    __syncthreads();
}

__device__ __forceinline__ void copyp_tile(const Ctx& c, int b) {
    const int tid = otid();
    for (int idx = tid; idx < 3 * 1536; idx += 512) { const int r = idx / 1536, ch = idx % 1536;
        c.out[O_CONVP + ((size_t)(c.l * 8 + b) * 3 + r) * 1536 + ch] = bf2f(c.U[(size_t)(b * PL + PL - 3 + r) * NU + U_XBC + ch]); }
    for (int idx = tid; idx < 128 * 128; idx += 512) { const int j = idx >> 7, ch = idx & 127; const size_t ur = (size_t)(b * PL + PL - 128 + j) * NU;
        c.out[O_KP + ((size_t)(c.l * 8 + b) * 128 + j) * 128 + ch] = bf2f(c.U[ur + U_KC + ch]);
        c.out[O_VP + ((size_t)(c.l * 8 + b) * 128 + j) * 128 + ch] = bf2f(c.U[ur + U_VC + ch]); }
}

__device__ __forceinline__ void sret_tile(const Ctx& c, int item, LAS unsigned char* lds) {
    const int tid = otid(), w = tid >> 6;
    const int h = item & 3, b = item >> 2, row = MPR + b;
    LAS float* qS = (LAS float*)lds; LAS float* kS = qS + 128; LAS float* vS = kS + 128; LAS float* part = vS + 128; LAS float* red = part + 512;
    const bf16_t* ur = c.U + (size_t)row * NU;
    if (tid < 64) { float cs, sn; rot_cs(PAST_POS, tid, cs, sn);
        const float ql = bf2f(ur[U_QR + h * 128 + tid]), qh = bf2f(ur[U_QR + h * 128 + 64 + tid]), kl = bf2f(ur[U_KR + h * 128 + tid]), kh = bf2f(ur[U_KR + h * 128 + 64 + tid]);
        qS[tid] = ql * cs - qh * sn; qS[64 + tid] = ql * sn + qh * cs; kS[tid] = (kl * cs - kh * sn) * 0.08838834764831845f; kS[64 + tid] = (kl * sn + kh * cs) * 0.08838834764831845f;
    } else if (tid < 192) vS[tid - 64] = bf2f(ur[U_VR + h * 128 + tid - 64]);
    __syncthreads();
    const int v = tid & 127, dq = tid >> 7; const float gamma = 1.f - exp2f(-5.f - (float)h), vv = vS[v];
    const size_t base = ((size_t)(c.l * 128 + b) * 4 + h) * 16384; const float* sin_ = c.in[2] + base; float* sout = c.out + O_RETS + base;
    float o = 0.f;
#pragma unroll 8
    for (int dd = 0; dd < 32; ++dd) { const int d = dq * 32 + dd; const float sn = gamma * sin_[d * 128 + v] + kS[d] * vv; sout[d * 128 + v] = sn; o += qS[d] * sn; }
    part[dq * 128 + v] = o;
    __syncthreads();
    float ov = 0.f;
    if (tid < 128) { ov = part[tid] + part[128 + tid] + part[256 + tid] + part[384 + tid]; const float s = wave_sum(ov); if ((tid & 63) == 0) red[w] = s; }
    __syncthreads();
    const float mean = (red[0] + red[1]) * (1.f / 128.f); const float dv = ov - mean;
    if (tid < 128) { const float s = wave_sum(dv * dv); if ((tid & 63) == 0) red[2 + w] = s; }
    __syncthreads();
    if (tid < 128) { const float rstd = rsqrtf((red[2] + red[3]) * (1.f / 128.f) + EPS); const float gt = siluf_(bf2f(ur[U_GR + h * 128 + tid]));
        c.ABR[(size_t)row * KBR + h * 128 + tid] = (bf16_t)f2bf(dv * rstd * gt); }
    __syncthreads();
}

__device__ __forceinline__ void sssd_tile(const Ctx& c, int item, LAS unsigned char* lds) {
    const int tid = otid();
    const int g = item & 1, b = item >> 1, row = MPR + b;
    LAS float* xS = (LAS float*)lds; LAS float* BS = xS + 512; LAS float* CS = BS + 128; LAS float* dtv = CS + 128; LAS float* ysq = dtv + 8; LAS float* prod = ysq + 512;
    const bf16_t* ur = c.U + (size_t)row * NU;
    for (int ch = tid; ch < 768; ch += 512) { const int cb = ch < 512 ? g * 512 + ch : (ch < 640 ? 1024 + g * 128 + (ch - 512) : 1280 + g * 128 + (ch - 640));
        const float* cw = c.in[8] + (size_t)c.l * 4 * 1536 + cb; const float* sc = c.in[4] + (size_t)(c.l * 128 + b) * 3 * 1536 + cb;
        float a = c.in[9][c.l * 1536 + cb] + cw[0] * sc[0] + cw[1536] * sc[1536] + cw[3072] * sc[3072] + cw[4608] * bf2f(ur[U_XBC + cb]);
        xS[ch] = siluf_(a); }
    if (tid < 8) dtv[tid] = softplusf_(bf2f(ur[U_DT + g * 8 + tid]) + c.in[10][c.l * 16 + g * 8 + tid]);
    __syncthreads();
    const int s = tid & 127, pq = tid >> 7;
    for (int hl = 0; hl < 8; ++hl) { const int h = g * 8 + hl; const float dt = dtv[hl], dA = __expf(dt * -__expf(c.in[11][c.l * 16 + h]));
        const size_t base = ((size_t)(c.l * 128 + b) * 16 + h) * 8192; const float* hin = c.in[3] + base; float* hout = c.out + O_SSMS + base;
        const float bs = BS[s] * dt, cv = CS[s];
#pragma unroll 8
        for (int pp = 0; pp < 16; ++pp) { const int p = pq * 16 + pp; const float hn = dA * hin[p * 128 + s] + xS[hl * 64 + p] * bs; hout[p * 128 + s] = hn; prod[p * 129 + s] = hn * cv; }
        __syncthreads();
        { const int p = tid >> 3, sub = tid & 7; float a = 0.f;
#pragma unroll
          for (int k = 0; k < 16; ++k) a += prod[p * 129 + sub * 16 + k];
          a += __shfl_xor(a, 1); a += __shfl_xor(a, 2); a += __shfl_xor(a, 4);
          if (sub == 0) { float y = a + c.in[12][c.l * 16 + h] * xS[hl * 64 + p]; y *= siluf_(bf2f(ur[U_Z + h * 64 + p])); c.ABR[(size_t)row * KBR + 512 + h * 64 + p] = (bf16_t)f2bf(y); ysq[hl * 64 + p] = y * y; } }
        __syncthreads();
    }
    if (tid < 64) { float a = 0.f;
#pragma unroll
        for (int k = 0; k < 8; ++k) a += ysq[tid * 8 + k];
        a = wave_sum(a); if (tid == 0) c.RSTD[row * 2 + g] = rsqrtf(a * (1.f / 512.f) + EPS); }
    __syncthreads();
}

__device__ __forceinline__ void sswa_tile(const Ctx& c, int b, LAS unsigned char* lds) {
    const int tid = otid(), w = tid >> 6, lane = tid & 63, row = MPR + b;
    LAS float* qS = (LAS float*)lds; LAS float* knew = qS + 512; LAS float* vnew = knew + 128; LAS float* pS = vnew + 128;
    const bf16_t* ur = c.U + (size_t)row * NU;
    qS[tid] = bf2f(ur[U_QC + tid]);
    if (tid < 128) knew[tid] = bf2f(ur[U_KC + tid]); else if (tid < 256) vnew[tid - 128] = bf2f(ur[U_VC + tid - 128]);
    __syncthreads();
    const int hq = w, kvh = w >> 2;
    const float* kc = c.in[5] + (size_t)(c.l * 128 + b) * 128 * 128 + kvh * 64; const float* vc = c.in[6] + (size_t)(c.l * 128 + b) * 128 * 128 + kvh * 64;
    float d0 = 0.f, d1 = 0.f, dn = 0.f;
#pragma unroll 4
    for (int d4 = 0; d4 < 16; ++d4) { const f32x4 q = *(const LAS f32x4*)(qS + hq * 64 + d4 * 4), k0 = *(const f32x4*)(kc + (size_t)lane * 128 + d4 * 4), k1 = *(const f32x4*)(kc + (size_t)(lane + 64) * 128 + d4 * 4), kn = *(const LAS f32x4*)(knew + kvh * 64 + d4 * 4);
        d0 += q[0] * k0[0] + q[1] * k0[1] + q[2] * k0[2] + q[3] * k0[3]; d1 += q[0] * k1[0] + q[1] * k1[1] + q[2] * k1[2] + q[3] * k1[3]; dn += q[0] * kn[0] + q[1] * kn[1] + q[2] * kn[2] + q[3] * kn[3]; }
    const float* rb = c.in[15];
    const float l0 = d0 * 0.125f + rb[T5_BUCKET[128 - lane] * 8 + hq], l1 = d1 * 0.125f + rb[T5_BUCKET[64 - lane] * 8 + hq], ln = dn * 0.125f + rb[hq], sink = c.in[14][c.l * 8 + hq];
    const float m = fmaxf(fmaxf(wave_max(fmaxf(l0, l1)), ln), sink);
    const float p0 = __expf(l0 - m), p1 = __expf(l1 - m), pn = __expf(ln - m);
    const float inv = 1.f / (wave_sum(p0 + p1) + pn + __expf(sink - m));
    pS[hq * 132 + lane] = p0 * inv; pS[hq * 132 + 64 + lane] = p1 * inv; if (lane == 0) pS[hq * 132 + 128] = pn * inv;
    __syncthreads();
    float o = pS[hq * 132 + 128] * vnew[kvh * 64 + lane];
#pragma unroll 8
    for (int j = 0; j < 128; ++j) o += pS[hq * 132 + j] * vc[(size_t)j * 128 + lane];
    c.ABR[(size_t)row * KBR + 1536 + hq * 64 + lane] = (bf16_t)f2bf(o);
    const size_t sb = (size_t)(c.l * 128 + b) * 128 * 128; const float* kin = c.in[5] + sb; const float* vin = c.in[6] + sb;
    for (int idx = tid; idx < 128 * 128; idx += 512) { const int j = idx >> 7, ch = idx & 127;
        c.out[O_KS + sb + idx] = j < 127 ? kin[idx + 128] : knew[ch]; c.out[O_VS + sb + idx] = j < 127 ? vin[idx + 128] : vnew[ch]; }
    const size_t cbs = (size_t)(c.l * 128 + b) * 3 * 1536;
    for (int ch = tid; ch < 1536; ch += 512) { c.out[O_CONVS + cbs + ch] = c.in[4][cbs + 1536 + ch]; c.out[O_CONVS + cbs + 1536 + ch] = c.in[4][cbs + 3072 + ch]; c.out[O_CONVS + cbs + 3072 + ch] = bf2f(ur[U_XBC + ch]); }
    __syncthreads();
}

__device__ __forceinline__ void scan_phase(const Ctx& c) {
    const int gt = blockIdx.x * 512 + otid(), NT = gridDim.x * 512;
    for (int i = gt; i < 8 * 4 * 4096; i += NT) { const int e4 = i & 4095, bh = i >> 12, h = bh & 3;
        const float cdec = __expf(__logf(1.f - exp2f(-5.f - (float)h)) * 128.f);
        float* p = c.KV + (size_t)bh * 16 * 16384 + e4 * 4; f32x4 run = (f32x4){0.f, 0.f, 0.f, 0.f};
#pragma unroll 4
        for (int n = 0; n < 16; ++n) { const f32x4 t = *(const f32x4*)(p + n * 16384); *(f32x4*)(p + n * 16384) = run; run = run * cdec + t; }
        *(f32x4*)(c.out + O_RETP + ((size_t)c.l * 32 + bh) * 16384 + e4 * 4) = run; }
    for (int i = gt; i < 8 * 16 * 2048; i += NT) { const int e4 = i & 2047, bh = i >> 11, h = bh & 15, b = bh >> 4;
        f32x4 run = (f32x4){0.f, 0.f, 0.f, 0.f};
#pragma unroll 4
        for (int n = 0; n < 16; ++n) { float* p = c.ST + ((size_t)((b * 16 + n) * 16 + h)) * 8192 + e4 * 4; const float dec = __expf(c.CSL[(b * 16 + n) * 16 + h]);
            const f32x4 t = *(const f32x4*)p; *(f32x4*)p = run; run = run * dec + t; }
        *(f32x4*)(c.out + O_SSMP + ((size_t)c.l * 128 + bh) * 8192 + e4 * 4) = run; }
}

constexpr int N_PHASES = 1 + NLAYER * 10;
#ifndef DISMASK
#define DISMASK 0
#endif
#define DIS(bit, stmt) do { if (!((DISMASK) & (bit))) { stmt; } } while (0)
__global__ void __launch_bounds__(512, 2) mega_fwd(Args a) {
    extern __shared__ __attribute__((aligned(16))) unsigned char lds_raw[];
    LAS unsigned char* lds = (LAS unsigned char*)lds_raw;
    cg::grid_group grid = cg::this_grid();
    Ctx c; c.in = a.in; c.out = a.out; c.ws = a.ws;
    c.XB = (bf16_t*)(a.ws + WS_XB); c.XF = (float*)(a.ws + WS_XF); c.U = (bf16_t*)(a.ws + WS_U); c.H = (bf16_t*)(a.ws + WS_U); c.ABR = (bf16_t*)(a.ws + WS_ABR);
    c.MIX = (float*)(a.ws + WS_MIX); c.MIXB = (bf16_t*)(a.ws + WS_MIXB); c.KV = (float*)(a.ws + WS_KV); c.ST = (float*)(a.ws + WS_ST); c.CSL = (float*)(a.ws + WS_CSL); c.RSTD = (float*)(a.ws + WS_RSTD);
    const int G = gridDim.x, bx = blockIdx.x;
    for (int ph = a.ph_lo; ph < a.ph_hi; ++ph) {
        if (ph == 0) { c.l = 0; DIS(1024, prologue(c, lds)); }
        else {
            const int l = (ph - 1) / 10, s = (ph - 1) % 10; c.l = l;
            if (s == 0) {
                pg8::Gemm g{c.XB, wl(a.ws, l, OFF_WIN), MP, NU, DM, DM, DM}; pg8::StaticOrder S; S.init(MP, NU, G, bx);
                EpiBf16 E{c.U, NU}; DIS(2048, (pg8::gemm_phase<EpiBf16, true>(lds, g, S, E)));
            } else if (s == 1) {
                for (int it = bx; it < 1928; it += G) {
                    if (it < 256) { DIS(1, swa_tile(c, it, lds)); }
                    else if (it < 512) { DIS(2, ssd1_tile(c, it - 256, lds)); }
                    else if (it < 1024) { DIS(4, ret1_tile(c, it - 512, lds)); }
                    else if (it < 1536) { DIS(8, sret_tile(c, it - 1024, lds)); }
                    else if (it < 1792) { DIS(16, sssd_tile(c, it - 1536, lds)); }
                    else if (it < 1920) { DIS(32, sswa_tile(c, it - 1792, lds)); }
                    else { DIS(64, copyp_tile(c, it - 1920)); }
                }
            } else if (s == 2) { DIS(512, scan_phase(c)); }
            else if (s == 3) {
                for (int it = bx; it < 768; it += G) { if (it < 256) { DIS(128, ssd2_tile(c, it, lds)); } else { DIS(256, ret2_tile(c, it - 256, lds)); } }
            } else if (s == 4) {
                for (int br = 0; br < 4; ++br) {
                    pg8::Gemm g{c.ABR + br * 512, wl(a.ws, l, OFF_WBR) + br * 512, MP, DM, 512, KBR, KBR}; pg8::StaticOrder S; S.init(MP, DM, G, bx);
                    EpiBranch E{c.U, c.RSTD, c.MIX, c.MIXB, br}; DIS(4096, (pg8::gemm_phase<EpiBranch, true>(lds, g, S, E)));
                }
            } else if (s == 5 || s == 8) {
                pg8::Gemm g{s == 5 ? c.MIXB : c.H, wl(a.ws, l, s == 5 ? OFF_WOUT : OFF_WDN), MP, DM, s == 5 ? DM : DFF, s == 5 ? DM : DFF, s == 5 ? DM : DFF}; pg8::StaticOrder S; S.init(MP, DM, G, bx);
                EpiRes E{c.XF, c.MIX}; DIS(8192, (pg8::gemm_phase<EpiRes, true>(lds, g, S, E)));
            } else if (s == 6 || s == 9) {
                const bool fin = (s == 9 && l == NLAYER - 1);
                DIS(32768, ln_phase(c, c.in[s == 6 ? 20 : 22] + l * DM, c.in[s == 6 ? 21 : 23] + l * DM, fin));
            } else {
                pg8::Gemm g{c.XB, wl(a.ws, l, OFF_WGU), MP, 2 * DFF, DM, DM, DM}; pg8::StaticOrder S; S.init(MP, 2 * DFF, G, bx);
                EpiGU E{c.H}; DIS(16384, (pg8::gemm_phase<EpiGU, true>(lds, g, S, E)));
            }
        }
        if (ph + 1 < a.ph_hi) grid.sync();
    }
}

#ifndef MK_PER_PHASE
#define MK_PER_PHASE 0
#endif
extern "C" void kernel_launch(void* const* d_in, const int* in_sizes, int n_in, void* d_out, int out_size, void* d_ws, size_t ws_size, hipStream_t stream) {
    static int grid = 0;
    if (grid == 0) {
        if (n_in != 27 || (size_t)out_size != O_END || ws_size < WS_END) { fprintf(stderr, "kernel_launch: unexpected shapes: n_in %d out %d (want %zu) ws %zu (want %zu)\n", n_in, out_size, (size_t)O_END, ws_size, (size_t)WS_END); grid = -1; return; }
        int dev = 0, cus = 0, per_cu = 0;
        hipGetDevice(&dev); hipDeviceGetAttribute(&cus, hipDeviceAttributeMultiprocessorCount, dev);
        if (hipFuncSetAttribute((const void*)mega_fwd, hipFuncAttributeMaxDynamicSharedMemorySize, LDS_BYTES) != hipSuccess) { fprintf(stderr, "kernel_launch: hipFuncSetAttribute failed\n"); grid = -1; return; }
        if (hipOccupancyMaxActiveBlocksPerMultiprocessor(&per_cu, (const void*)mega_fwd, 512, LDS_BYTES) != hipSuccess || per_cu < 1) { fprintf(stderr, "kernel_launch: occupancy query says %d\n", per_cu); per_cu = 1; }
        (void)hipGetLastError();
        grid = cus * per_cu;
    }
    if (grid < 0) return;
    Args a{};
    for (int i = 0; i < 27; ++i) a.in[i] = (const float*)d_in[i];
    a.out = (float*)d_out; a.ws = (unsigned char*)d_ws;
#if MK_PER_PHASE
    for (int ph = 0; ph < N_PHASES; ++ph) { a.ph_lo = ph; a.ph_hi = ph + 1; hipLaunchKernelGGL(mega_fwd, dim3(grid), dim3(512), LDS_BYTES, stream, a); }
#else
    a.ph_lo = 0; a.ph_hi = N_PHASES;
    void* args[] = {&a};
    hipError_t e = hipLaunchCooperativeKernel((const void*)mega_fwd, dim3(grid), dim3(512), args, LDS_BYTES, stream);
    if (e != hipSuccess) fprintf(stderr, "cooperative launch failed: %s (grid %d)\n", hipGetErrorString(e), grid);
#endif
}
```

```cpp
#include <hip/hip_runtime.h>
#include <hip/hip_cooperative_groups.h>
#include <cstdio>
#include <cstdint>
namespace cg = cooperative_groups;

#define LAS __attribute__((address_space(3)))
typedef unsigned short bf16_t;
typedef short bf16x8 __attribute__((ext_vector_type(8)));
typedef float f32x4 __attribute__((ext_vector_type(4)));
typedef float f32x2 __attribute__((ext_vector_type(2)));
typedef unsigned u32x4 __attribute__((ext_vector_type(4)));
typedef unsigned u32x2 __attribute__((ext_vector_type(2)));

constexpr int DM = 1024, NLAYER = 4;
constexpr int PB = 8, PL = 2048, MPR = PB * PL;
constexpr int SB = 128;
constexpr int MREAL = MPR + SB;
constexpr int MP = 16640;
constexpr int NIN = 8464, NU = 8704;
constexpr int DFF = 2816;
constexpr int KBR = 2048;
constexpr int U_QR = 0, U_KR = 512, U_VR = 1024, U_GR = 1536, U_Z = 2048, U_XBC = 3072, U_QC = 4608, U_KC = 5120, U_VC = 5248, U_GATE = 5376, U_DT = 8448;
constexpr float ALPHA = 1.681792830507429f;
constexpr float EPS = 1e-5f;
constexpr float PAST_POS = 8192.f;

constexpr size_t SZ_WIN = (size_t)NU * DM * 2, SZ_WBR = (size_t)DM * KBR * 2, SZ_WOUT = (size_t)DM * DM * 2, SZ_WGU = (size_t)2 * DFF * DM * 2, SZ_WDN = (size_t)DM * DFF * 2;
constexpr size_t SZ_WL = SZ_WIN + SZ_WBR + SZ_WOUT + SZ_WGU + SZ_WDN;
constexpr size_t WS_W = 0;
constexpr size_t WS_XB = WS_W + NLAYER * SZ_WL;
constexpr size_t WS_XF = WS_XB + (size_t)MP * DM * 2;
constexpr size_t WS_U = WS_XF + (size_t)MP * DM * 4;
constexpr size_t WS_ABR = WS_U + (size_t)MP * NU * 2;
constexpr size_t WS_MIX = WS_ABR + (size_t)MP * KBR * 2;
constexpr size_t WS_MIXB = WS_MIX + (size_t)MP * DM * 4;
constexpr size_t WS_KV = WS_MIXB + (size_t)MP * DM * 2;
constexpr size_t WS_ST = WS_KV + (size_t)8 * 4 * 16 * 16384 * 4;
constexpr size_t WS_CSL = WS_ST + (size_t)8 * 16 * 16 * 8192 * 4;
constexpr size_t WS_RSTD = WS_CSL + 8192;
constexpr size_t WS_CTL = WS_RSTD + (size_t)MP * 2 * 4;
constexpr size_t CTL_BYTES = 16384;
constexpr size_t WS_END = WS_CTL + CTL_BYTES;

constexpr size_t O_Y = 0;
constexpr size_t O_RETP = (size_t)MREAL * DM;
constexpr size_t O_SSMP = O_RETP + (size_t)4 * 8 * 4 * 16384;
constexpr size_t O_CONVP = O_SSMP + (size_t)4 * 8 * 16 * 8192;
constexpr size_t O_KP = O_CONVP + (size_t)4 * 8 * 3 * 1536;
constexpr size_t O_VP = O_KP + (size_t)4 * 8 * 128 * 128;
constexpr size_t O_RETS = O_VP + (size_t)4 * 8 * 128 * 128;
constexpr size_t O_SSMS = O_RETS + (size_t)4 * 128 * 4 * 16384;
constexpr size_t O_CONVS = O_SSMS + (size_t)4 * 128 * 16 * 8192;
constexpr size_t O_KS = O_CONVS + (size_t)4 * 128 * 3 * 1536;
constexpr size_t O_VS = O_KS + (size_t)4 * 128 * 128 * 128;
constexpr size_t O_END = O_VS + (size_t)4 * 128 * 128 * 128;

constexpr int LDS_BYTES = 147456;

__device__ const unsigned char T5_BUCKET[132] = {0, 1, 2, 3, 4, 5, 6, 7, 8, 9, 10, 11, 12, 13, 14, 15, 16, 16, 16, 17, 17, 18, 18, 18, 19, 19, 19, 20, 20, 20, 20, 21, 21, 21, 21, 22, 22, 22, 22, 22, 23, 23, 23, 23, 23, 23, 24, 24, 24, 24, 24, 24, 25, 25, 25, 25, 25, 25, 25, 26, 26, 26, 26, 26, 26, 26, 26, 27, 27, 27, 27, 27, 27, 27, 27, 27, 27, 28, 28, 28, 28, 28, 28, 28, 28, 28, 28, 29, 29, 29, 29, 29, 29, 29, 29, 29, 29, 29, 29, 30, 30, 30, 30, 30, 30, 30, 30, 30, 30, 30, 30, 30, 30, 31, 31, 31, 31, 31, 31, 31, 31, 31, 31, 31, 31, 31, 31, 31, 31, 31, 31, 31};

__device__ __forceinline__ int otid() { int t = threadIdx.x; asm volatile("" : "+v"(t)); return t; }
__device__ __forceinline__ float bf2f(unsigned short h) { return __uint_as_float(((unsigned)h) << 16); }
__device__ __forceinline__ unsigned f2bf(float f) { unsigned u = __float_as_uint(f); return (u + 0x7fffu + ((u >> 16) & 1u)) >> 16; }
__device__ __forceinline__ unsigned pk2(float lo, float hi) { return f2bf(lo) | (f2bf(hi) << 16); }
__device__ __forceinline__ float lo16(unsigned v) { return __uint_as_float(v << 16); }
__device__ __forceinline__ float hi16(unsigned v) { return __uint_as_float(v & 0xffff0000u); }
#define UNPACK8(v, f) do { f[0] = lo16((v).x); f[1] = hi16((v).x); f[2] = lo16((v).y); f[3] = hi16((v).y); f[4] = lo16((v).z); f[5] = hi16((v).z); f[6] = lo16((v).w); f[7] = hi16((v).w); } while (0)
__device__ __forceinline__ float sigmoidf_(float x) { return 1.f / (1.f + __expf(-x)); }
__device__ __forceinline__ float siluf_(float x) { return x / (1.f + __expf(-x)); }
__device__ __forceinline__ float softplusf_(float x) { return x > 20.f ? x : log1pf(__expf(x)); }
__device__ __forceinline__ float wave_sum(float v) {
#pragma unroll
    for (int o = 1; o < 64; o <<= 1) v += __shfl_xor(v, o);
    return v;
}
__device__ __forceinline__ float wave_max(float v) {
#pragma unroll
    for (int o = 1; o < 64; o <<= 1) v = fmaxf(v, __shfl_xor(v, o));
    return v;
}
__device__ __forceinline__ void rot_cs(float pos, int i, float& c, float& s) {
    const float ci = __builtin_amdgcn_exp2f(-(float)i * 0.20762050593046014f) * 0.15915494309189535f;
    float rev = pos * ci; rev = rev - floorf(rev);
    s = __builtin_amdgcn_sinf(rev); c = __builtin_amdgcn_cosf(rev);
}

namespace pg8 {
constexpr int BM = 256, BK = 64, HALF = 128, HTB = HALF * BK * 2, STAGE_BYTES = 8 * HTB, NXCD = 8, WGM = 8;
__host__ __device__ __forceinline__ int lds_byte(int r, int c) { const int st = (r >> 4) * 2 + (c >> 5), rr = r & 15, cc = c & 31, ob = rr * 64 + cc * 2; return st * 1024 + (ob ^ (((ob >> 9) & 1) << 5)); }
__host__ __device__ __forceinline__ void stage_rc(int b, int& R, int& C) { const int st = b / 1024, sb = b % 1024, swz = sb ^ (((sb >> 9) & 1) << 5); R = (st >> 1) * 16 + swz / 64; C = (st & 1) * 32 + (swz % 64) / 2; }
__host__ __device__ __forceinline__ int perm32(int rho) { const int n = rho >> 4, i = rho & 15; return 8 * (i >> 2) + 4 * n + (i & 3); }
struct Unit { int pm, pn; };
struct Gemm { const bf16_t* A; const bf16_t* Bt; int M, N, K, lda, ldb; };
struct StaticOrder {
    int nM, nN, nwg, G, c;
    __device__ void init(int M, int N, int G_, int c_) { nM = M / BM; nN = N / BM; nwg = nM * nN; G = G_; c = c_; }
    __device__ bool next(int i, Unit& u) const {
        const long L = (long)i * G + c; if (L >= nwg) return false;
        int wgid = (int)L; { const int q = nwg / NXCD, r = nwg % NXCD, xcd = wgid % NXCD, off = wgid / NXCD; wgid = (xcd < r ? xcd * (q + 1) : r * (q + 1) + (xcd - r) * q) + off; }
        const int nig = WGM * nN, gid = wgid / nig, fm = gid * WGM, gsz = (nM - fm) < WGM ? (nM - fm) : WGM;
        u.pm = fm + ((wgid % nig) % gsz); u.pn = (wgid % nig) / gsz; return true;
    }
};
template <class Epi, bool ALIGN_EPI>
__device__ __forceinline__ void gemm_phase(LAS unsigned char* lds, const Gemm g, const StaticOrder& S, const Epi& E) {
    const int tid = otid(), wid = __builtin_amdgcn_readfirstlane(tid >> 6), lane = tid & 63, wr = wid >> 2, wc = wid & 3, fr = lane & 15, fq = lane >> 4;
    const int K = g.K, nt = K / BK;
    unsigned voffA[2], voffB[2];
#pragma unroll
    for (int i = 0; i < 2; ++i) { int R, C; stage_rc(tid * 16 + i * 8192, R, C); const int Rb = (R & ~31) + perm32(R & 31);
        voffA[i] = (unsigned)(R * g.lda + C) * 2u; voffB[i] = (unsigned)(Rb * g.ldb + C) * 2u; }
    const size_t kstep = (size_t)(BK * 2);
    const size_t hstepA = (size_t)HALF * g.lda * 2, hstepB = (size_t)HALF * g.ldb * 2;
    const size_t tstepA = 2 * hstepA, tstepB = 2 * hstepB;
    const unsigned ldsw = (unsigned)wid * 1024u;
    const int aoff = lds_byte(wr * 64 + fr, fq * 8), boff = lds_byte(wc * 32 + fr, fq * 8);
#define PG8_SA(b, h) (((b) * 2 + (h)) * HTB)
#define PG8_SB(b, h) ((4 + (b) * 2 + (h)) * HTB)
#define PG8_STAGE(bufoff, gbase, voff) do { _Pragma("unroll") for (int _i = 0; _i < 2; ++_i) \
        __builtin_amdgcn_global_load_lds((const unsigned*)((const char*)(gbase) + (voff)[_i]), (LAS unsigned*)(lds + (bufoff) + ldsw + _i * 8192), 16, 0, 0); } while (0)
#define PG8_LDA(dst, b, h) do { _Pragma("unroll") for (int m = 0; m < 4; ++m) _Pragma("unroll") for (int k = 0; k < 2; ++k) dst[m][k] = *(const LAS bf16x8*)(lds + PG8_SA(b, h) + aoff + m * 2048 + k * 1024); } while (0)
#define PG8_LDB(dst, b, h) do { _Pragma("unroll") for (int n = 0; n < 2; ++n) _Pragma("unroll") for (int k = 0; k < 2; ++k) dst[n][k] = *(const LAS bf16x8*)(lds + PG8_SB(b, h) + boff + n * 2048 + k * 1024); } while (0)
#define PG8_MMA(ai, bj, At, Bt) do { __builtin_amdgcn_s_setprio(1); _Pragma("unroll") for (int m = 0; m < 4; ++m) _Pragma("unroll") for (int n = 0; n < 2; ++n) _Pragma("unroll") for (int k = 0; k < 2; ++k) \
        acc[ai][bj][m][n] = __builtin_amdgcn_mfma_f32_16x16x32_bf16(Bt[n][k], At[m][k], acc[ai][bj][m][n], 0, 0, 0); __builtin_amdgcn_s_setprio(0); } while (0)
#define PG8_WAIT_V(n) asm volatile("s_waitcnt vmcnt(" #n ")" ::: "memory")
#define PG8_WAIT_L(n) asm volatile("s_waitcnt lgkmcnt(" #n ")" ::: "memory")
#define PG8_BAR __builtin_amdgcn_s_barrier()
#define PG8_SCHED __builtin_amdgcn_sched_barrier(0)
    Unit cur, nxt; int ui = 0;
    if (!S.next(0, cur)) return;
    f32x4 acc[2][2][4][2];
#pragma unroll
    for (int a = 0; a < 2; ++a)
#pragma unroll
        for (int b = 0; b < 2; ++b)
#pragma unroll
            for (int m = 0; m < 4; ++m)
#pragma unroll
                for (int n = 0; n < 2; ++n) acc[a][b][m][n] = (f32x4){0.f, 0.f, 0.f, 0.f};
    bf16x8 At[4][2], B0[2][2], B1[2][2];
    const char* cA = (const char*)g.A + (size_t)cur.pm * tstepA; const char* cB = (const char*)g.Bt + (size_t)cur.pn * tstepB;
    PG8_STAGE(PG8_SB(0, 0), cB, voffB); PG8_STAGE(PG8_SB(0, 1), cB + hstepB, voffB); PG8_STAGE(PG8_SA(0, 0), cA, voffA); PG8_STAGE(PG8_SA(0, 1), cA + hstepA, voffA);
    if (wr == 1) PG8_BAR;
    PG8_WAIT_V(2); PG8_BAR;
    PG8_STAGE(PG8_SB(1, 0), cB + kstep, voffB); PG8_STAGE(PG8_SA(1, 0), cA + kstep, voffA); PG8_STAGE(PG8_SB(1, 1), cB + hstepB + kstep, voffB);
    PG8_WAIT_V(6); PG8_BAR;
    for (;;) {
        const bool has_next = S.next(ui + 1, nxt);
        const char* nA = has_next ? (const char*)g.A + (size_t)nxt.pm * tstepA : cA; const char* nB = has_next ? (const char*)g.Bt + (size_t)nxt.pn * tstepB : cB;
        for (int t = 0; t < nt; t += 2) {
            const bool last = (t == nt - 2);
            const char* a1 = cA + (size_t)(t + 1) * kstep;
            const char* a2 = last ? nA : cA + (size_t)(t + 2) * kstep; const char* b2 = last ? nB : cB + (size_t)(t + 2) * kstep;
            const char* a3 = a2 + kstep; const char* b3 = b2 + kstep;
            PG8_LDB(B0, 0, 0); PG8_LDB(B1, 0, 1); PG8_SCHED; PG8_LDA(At, 0, 0); PG8_STAGE(PG8_SA(1, 1), a1 + hstepA, voffA);
            PG8_WAIT_V(8); PG8_WAIT_L(0); PG8_BAR; PG8_MMA(0, 0, At, B0); PG8_MMA(0, 1, At, B1); PG8_BAR; PG8_SCHED;
            PG8_LDA(At, 0, 1); PG8_STAGE(PG8_SB(0, 0), b2, voffB); PG8_STAGE(PG8_SB(0, 1), b2 + hstepB, voffB); PG8_STAGE(PG8_SA(0, 0), a2, voffA);
            PG8_WAIT_V(8); PG8_WAIT_L(0); PG8_BAR; PG8_MMA(1, 0, At, B0); PG8_MMA(1, 1, At, B1); PG8_BAR; PG8_SCHED;
            PG8_LDB(B0, 1, 0); PG8_LDB(B1, 1, 1); PG8_SCHED; PG8_LDA(At, 1, 0); PG8_STAGE(PG8_SA(0, 1), a2 + hstepA, voffA);
            PG8_WAIT_V(8); PG8_WAIT_L(0); PG8_BAR; PG8_MMA(0, 0, At, B0); PG8_MMA(0, 1, At, B1); PG8_BAR; PG8_SCHED;
            PG8_LDA(At, 1, 1); PG8_STAGE(PG8_SB(1, 0), b3, voffB); PG8_STAGE(PG8_SB(1, 1), b3 + hstepB, voffB); PG8_STAGE(PG8_SA(1, 0), a3, voffA);
            PG8_WAIT_V(8); PG8_WAIT_L(0); PG8_BAR; PG8_MMA(1, 0, At, B0); PG8_MMA(1, 1, At, B1); PG8_BAR; PG8_SCHED;
        }
        if constexpr (ALIGN_EPI) { if (wr == 0) PG8_BAR; }
        E(acc, cur, wr, wc, fr, fq);
        if (!has_next) break;
#pragma unroll
        for (int a = 0; a < 2; ++a)
#pragma unroll
            for (int b = 0; b < 2; ++b)
#pragma unroll
                for (int m = 0; m < 4; ++m)
#pragma unroll
                    for (int n = 0; n < 2; ++n) acc[a][b][m][n] = (f32x4){0.f, 0.f, 0.f, 0.f};
        cur = nxt; cA = nA; cB = nB; ++ui;
        if constexpr (ALIGN_EPI) { if (wr == 1) PG8_BAR; }
    }
    PG8_WAIT_V(0);
    if constexpr (!ALIGN_EPI) { if (wr == 0) PG8_BAR; }
    PG8_BAR;
#undef PG8_SA
#undef PG8_SB
#undef PG8_STAGE
#undef PG8_LDA
#undef PG8_LDB
#undef PG8_MMA
#undef PG8_WAIT_V
#undef PG8_WAIT_L
#undef PG8_BAR
#undef PG8_SCHED
}
}

struct EpiBf16 {
    bf16_t* O; int ldc;
    __device__ __forceinline__ void operator()(const f32x4 (&acc)[2][2][4][2], const pg8::Unit& u, int wr, int wc, int fr, int fq) const {
        const int row0 = u.pm * 256 + wr * 64 + fr, col0 = u.pn * 256 + wc * 32 + 8 * fq;
#pragma unroll
        for (int ai = 0; ai < 2; ++ai)
#pragma unroll
            for (int m = 0; m < 4; ++m) { bf16_t* rowp = O + (size_t)(row0 + ai * 128 + m * 16) * ldc + col0;
#pragma unroll
                for (int bj = 0; bj < 2; ++bj) { const f32x4 v0 = acc[ai][bj][m][0], v1 = acc[ai][bj][m][1];
                    u32x4 w; w.x = pk2(v0[0], v0[1]); w.y = pk2(v0[2], v0[3]); w.z = pk2(v1[0], v1[1]); w.w = pk2(v1[2], v1[3]);
                    *(u32x4*)(rowp + bj * 128) = w; } }
    }
};
struct EpiGU {
    bf16_t* H;
    __device__ __forceinline__ void operator()(const f32x4 (&acc)[2][2][4][2], const pg8::Unit& u, int wr, int wc, int fr, int fq) const {
        const int row0 = u.pm * 256 + wr * 64 + fr, col0 = u.pn * 256 + wc * 32 + 8 * fq;
#pragma unroll
        for (int ai = 0; ai < 2; ++ai)
#pragma unroll
            for (int m = 0; m < 4; ++m) { bf16_t* rowp = H + (size_t)(row0 + ai * 128 + m * 16) * DFF + (col0 >> 1);
#pragma unroll
                for (int bj = 0; bj < 2; ++bj) { const f32x4 v0 = acc[ai][bj][m][0], v1 = acc[ai][bj][m][1];
                    u32x2 w; w.x = pk2(siluf_(v0[0]) * v1[0], siluf_(v0[1]) * v1[1]); w.y = pk2(siluf_(v0[2]) * v1[2], siluf_(v0[3]) * v1[3]);
                    *(u32x2*)(rowp + bj * 64) = w; } }
    }
};
struct EpiRes {
    const float* X; float* V;
    __device__ __forceinline__ void operator()(const f32x4 (&acc)[2][2][4][2], const pg8::Unit& u, int wr, int wc, int fr, int fq) const {
        const int row0 = u.pm * 256 + wr * 64 + fr, col0 = u.pn * 256 + wc * 32 + 8 * fq;
#pragma unroll
        for (int ai = 0; ai < 2; ++ai)
#pragma unroll
            for (int m = 0; m < 4; ++m) { const size_t off = (size_t)(row0 + ai * 128 + m * 16) * DM + col0;
#pragma unroll
                for (int bj = 0; bj < 2; ++bj) {
                    const f32x4 x0 = *(const f32x4*)(X + off + bj * 128), x1 = *(const f32x4*)(X + off + bj * 128 + 4);
                    *(f32x4*)(V + off + bj * 128) = x0 * ALPHA + acc[ai][bj][m][0]; *(f32x4*)(V + off + bj * 128 + 4) = x1 * ALPHA + acc[ai][bj][m][1]; } }
    }
};
struct EpiBranch {
    const bf16_t* U; const float* RSTD; float* MIX; bf16_t* MIXB; int br;
    __device__ __forceinline__ void operator()(const f32x4 (&acc)[2][2][4][2], const pg8::Unit& u, int wr, int wc, int fr, int fq) const {
        const int row0 = u.pm * 256 + wr * 64 + fr, col0 = u.pn * 256 + wc * 32 + 8 * fq;
        const int gcol = U_GATE + (br == 0 ? 0 : (br == 3 ? 2048 : 1024));
#pragma unroll
        for (int ai = 0; ai < 2; ++ai)
#pragma unroll
            for (int m = 0; m < 4; ++m) { const int row = row0 + ai * 128 + m * 16; const size_t off = (size_t)row * DM + col0;
                float rs = 1.f; if (br == 1) rs = RSTD[row * 2]; else if (br == 2) rs = RSTD[row * 2 + 1];
#pragma unroll
                for (int bj = 0; bj < 2; ++bj) {
                    const u32x4 gv = *(const u32x4*)(U + (size_t)row * NU + gcol + col0 + bj * 128); float gf[8]; UNPACK8(gv, gf);
                    f32x4 v0 = acc[ai][bj][m][0], v1 = acc[ai][bj][m][1];
#pragma unroll
                    for (int e = 0; e < 4; ++e) { v0[e] *= rs * sigmoidf_(gf[e]); v1[e] *= rs * sigmoidf_(gf[4 + e]); }
                    float* mp = MIX + off + bj * 128;
                    if (br != 0) { v0 += *(const f32x4*)mp; v1 += *(const f32x4*)(mp + 4); }
                    if (br != 3) { *(f32x4*)mp = v0; *(f32x4*)(mp + 4) = v1; }
                    else { u32x4 w; w.x = pk2(v0[0], v0[1]); w.y = pk2(v0[2], v0[3]); w.z = pk2(v1[0], v1[1]); w.w = pk2(v1[2], v1[3]); *(u32x4*)(MIXB + off + bj * 128) = w; } } }
    }
};

struct Args { const float* in[27]; float* out; unsigned char* ws; int ph_lo, ph_hi; };
struct Ctx {
    const float* const* in; float* out; unsigned char* ws;
    bf16_t *XB, *U, *ABR, *MIXB, *H; float *XF, *MIX, *KV, *ST, *CSL, *RSTD;
    int l;
};

template <int NB, int KS>
__device__ __forceinline__ void mm_strip(f32x4 (&acc)[NB], const LAS unsigned char* A, int lda_b, const LAS unsigned char* Bt, int ldb_b, int fr, int fq) {
#pragma unroll
    for (int ks = 0; ks < KS; ++ks) {
        const bf16x8 a = *(const LAS bf16x8*)(A + fr * lda_b + ks * 64 + fq * 16);
#pragma unroll
        for (int nb = 0; nb < NB; ++nb) {
            const bf16x8 b = *(const LAS bf16x8*)(Bt + (nb * 16 + fr) * ldb_b + ks * 64 + fq * 16);
            acc[nb] = __builtin_amdgcn_mfma_f32_16x16x32_bf16(b, a, acc[nb], 0, 0, 0);
        }
    }
}

__device__ __forceinline__ int dest_row(int mode, int n) {
    if (mode == 1) return n < 4608 ? n : (n < 4624 ? 8448 + (n - 4608) : n - 16);
    if (mode == 2) return 8 * (n >> 2) + (n & 3);
    if (mode == 3) return 8 * (n >> 2) + 4 + (n & 3);
    return n;
}
__device__ __forceinline__ void transpose_item(const float* W, int K, int N, bf16_t* WT, int ldk, int koff, int mode, const float* kscale, LAS float* scr, int item, int lane) {
    const int nblk = (N + 31) / 32, kb = item / nblk, nb = item % nblk, k0 = 64 * kb, n0 = 32 * nb;
    const int nn = n0 + (lane & 31);
#pragma unroll 8
    for (int i = 0; i < 32; ++i) { const int kk = 2 * i + (lane >> 5); float v = 0.f; if (nn < N) { v = W[(size_t)(k0 + kk) * N + nn]; if (kscale) v *= kscale[k0 + kk]; } scr[kk * 33 + (lane & 31)] = v; }
    asm volatile("s_waitcnt lgkmcnt(0)" ::: "memory");
    const int c = lane & 7;
#pragma unroll
    for (int j = 0; j < 4; ++j) { const int n = (lane >> 3) + 8 * j; const LAS float* s = scr + (8 * c) * 33 + n;
        u32x4 o; o.x = pk2(s[0 * 33], s[1 * 33]); o.y = pk2(s[2 * 33], s[3 * 33]); o.z = pk2(s[4 * 33], s[5 * 33]); o.w = pk2(s[6 * 33], s[7 * 33]);
        if (n0 + n < N) *(u32x4*)(WT + (size_t)dest_row(mode, n0 + n) * ldk + koff + k0 + 8 * c) = o; }
    asm volatile("s_waitcnt lgkmcnt(0)" ::: "memory");
}
__device__ __forceinline__ bf16_t* wl(unsigned char* ws, int l, size_t off) { return (bf16_t*)(ws + WS_W + (size_t)l * SZ_WL + off); }
constexpr size_t OFF_WIN = 0, OFF_WBR = SZ_WIN, OFF_WOUT = OFF_WBR + SZ_WBR, OFF_WGU = OFF_WOUT + SZ_WOUT, OFF_WDN = OFF_WGU + SZ_WGU;

__device__ __forceinline__ void prologue(const Ctx& c, LAS unsigned char* lds) {
    const int tid = otid(), wave = tid >> 6, lane = tid & 63;
    const int G = gridDim.x, gw = blockIdx.x * 8 + wave, NGW = G * 8;
    LAS float* scr = (LAS float*)(lds + wave * 16384);
    constexpr int I_IN = 16 * 265, I_R = 8 * 32, I_S = 16 * 32, I_O = 16 * 32, I_G = 16 * 88, I_D = 44 * 32;
    constexpr int I_LAYER = I_IN + I_R + I_S + I_R + I_O + I_G + I_G + I_D;
    for (int it = gw; it < NLAYER * I_LAYER; it += NGW) {
        const int l = it / I_LAYER; int r = it % I_LAYER;
        if (r < I_IN) { transpose_item(c.in[7] + (size_t)l * DM * NIN, DM, NIN, wl(c.ws, l, OFF_WIN), DM, 0, 1, nullptr, scr, r, lane); continue; } r -= I_IN;
        if (r < I_R) { transpose_item(c.in[16] + (size_t)l * 512 * DM, 512, DM, wl(c.ws, l, OFF_WBR), KBR, 0, 0, nullptr, scr, r, lane); continue; } r -= I_R;
        if (r < I_S) { transpose_item(c.in[17] + (size_t)l * 1024 * DM, 1024, DM, wl(c.ws, l, OFF_WBR), KBR, 512, 0, c.in[13] + l * 1024, scr, r, lane); continue; } r -= I_S;
        if (r < I_R) { transpose_item(c.in[18] + (size_t)l * 512 * DM, 512, DM, wl(c.ws, l, OFF_WBR), KBR, 1536, 0, nullptr, scr, r, lane); continue; } r -= I_R;
        if (r < I_O) { transpose_item(c.in[19] + (size_t)l * DM * DM, DM, DM, wl(c.ws, l, OFF_WOUT), DM, 0, 0, nullptr, scr, r, lane); continue; } r -= I_O;
        if (r < I_G) { transpose_item(c.in[24] + (size_t)l * DM * DFF, DM, DFF, wl(c.ws, l, OFF_WGU), DM, 0, 2, nullptr, scr, r, lane); continue; } r -= I_G;
        if (r < I_G) { transpose_item(c.in[25] + (size_t)l * DM * DFF, DM, DFF, wl(c.ws, l, OFF_WGU), DM, 0, 3, nullptr, scr, r, lane); continue; } r -= I_G;
        transpose_item(c.in[26] + (size_t)l * DFF * DM, DFF, DM, wl(c.ws, l, OFF_WDN), DFF, 0, 0, nullptr, scr, r, lane);
    }
    const int gt = blockIdx.x * 512 + tid, NT = G * 512;
    for (int i = gt; i < NLAYER * 240 * 128; i += NT) { const int l = i / (240 * 128), r = i % (240 * 128); *(u32x4*)(wl(c.ws, l, OFF_WIN) + (size_t)(NIN + r / 128) * DM + (r % 128) * 8) = (u32x4){0u, 0u, 0u, 0u}; }
    for (int i = gt; i < MP * (DM / 4); i += NT) { const int row = i >> 8, c4 = (i & 255) * 4;
        f32x4 v = (f32x4){0.f, 0.f, 0.f, 0.f};
        if (row < MPR) v = *(const f32x4*)(c.in[0] + (size_t)row * DM + c4); else if (row < MREAL) v = *(const f32x4*)(c.in[1] + (size_t)(row - MPR) * DM + c4);
        *(f32x4*)(c.XF + (size_t)row * DM + c4) = v; u32x2 w; w.x = pk2(v[0], v[1]); w.y = pk2(v[2], v[3]); *(u32x2*)(c.XB + (size_t)row * DM + c4) = w; }
}

__device__ __forceinline__ void ln_phase(const Ctx& c, const float* g, const float* b, bool final_out) {
    const int tid = otid(), wave = tid >> 6, lane = tid & 63;
    const int gw = blockIdx.x * 8 + wave, NGW = gridDim.x * 8;
    for (int row = gw; row < MREAL; row += NGW) {
        const f32x4* xr = (const f32x4*)(c.MIX + (size_t)row * DM) + lane;
        f32x4 v[4]; float s = 0.f;
#pragma unroll
        for (int j = 0; j < 4; ++j) { v[j] = xr[64 * j]; s += (v[j][0] + v[j][1]) + (v[j][2] + v[j][3]); }
        const float mean = wave_sum(s) * (1.f / DM); float s2 = 0.f;
#pragma unroll
        for (int j = 0; j < 4; ++j) { v[j] = v[j] - mean; s2 += (v[j][0] * v[j][0] + v[j][1] * v[j][1]) + (v[j][2] * v[j][2] + v[j][3] * v[j][3]); }
        const float rstd = rsqrtf(wave_sum(s2) * (1.f / DM) + EPS);
#pragma unroll
        for (int j = 0; j < 4; ++j) { const int col = (lane + 64 * j) * 4; const f32x4 gg = *(const f32x4*)(g + col), bb = *(const f32x4*)(b + col);
            const f32x4 o = v[j] * rstd * gg + bb;
            if (final_out) *(f32x4*)(c.out + O_Y + (size_t)row * DM + col) = o;
            else { *(f32x4*)(c.XF + (size_t)row * DM + col) = o; u32x2 w; w.x = pk2(o[0], o[1]); w.y = pk2(o[2], o[3]); *(u32x2*)(c.XB + (size_t)row * DM + col) = w; } }
    }
}

__device__ __forceinline__ void conv8(const Ctx& c, int row, int t, int cb, float (&o)[8]) {
    const float* cw = c.in[8] + (size_t)c.l * 4 * 1536 + cb; const float* cbias = c.in[9] + (size_t)c.l * 1536 + cb;
    { const f32x4 b0 = *(const f32x4*)cbias, b1 = *(const f32x4*)(cbias + 4); o[0] = b0[0]; o[1] = b0[1]; o[2] = b0[2]; o[3] = b0[3]; o[4] = b1[0]; o[5] = b1[1]; o[6] = b1[2]; o[7] = b1[3]; }
#pragma unroll
    for (int tau = 0; tau < 4; ++tau) {
        const int dt = tau - 3;
        if (t + dt >= 0) {
            const u32x4 xv = *(const u32x4*)(c.U + (size_t)(row + dt) * NU + U_XBC + cb); float xf[8]; UNPACK8(xv, xf);
            const f32x4 w0 = *(const f32x4*)(cw + tau * 1536), w1 = *(const f32x4*)(cw + tau * 1536 + 4);
            o[0] += w0[0] * xf[0]; o[1] += w0[1] * xf[1]; o[2] += w0[2] * xf[2]; o[3] += w0[3] * xf[3]; o[4] += w1[0] * xf[4]; o[5] += w1[1] * xf[5]; o[6] += w1[2] * xf[6]; o[7] += w1[3] * xf[7];
        }
    }
#pragma unroll
    for (int e = 0; e < 8; ++e) o[e] = siluf_(o[e]);
}
__device__ __forceinline__ void ssd_dtcs(const Ctx& c, int row0, int g, LAS float* dtS, LAS float* csS, int w, int lane, float* csl_out) {
    const int h = g * 8 + w;
    const float bias = c.in[10][c.l * 16 + h], a = -__expf(c.in[11][c.l * 16 + h]);
    const int j = 2 * lane;
    const float d0 = softplusf_(bf2f(c.U[(size_t)(row0 + j) * NU + U_DT + h]) + bias), d1 = softplusf_(bf2f(c.U[(size_t)(row0 + j + 1) * NU + U_DT + h]) + bias);
    const float v0 = d0 * a, v1 = d1 * a; float s = v0 + v1;
#pragma unroll
    for (int o = 1; o < 64; o <<= 1) { const float t = __shfl_up(s, o); if (lane >= o) s += t; }
    const float ex = s - (v0 + v1);
    dtS[w * 128 + j] = d0; dtS[w * 128 + j + 1] = d1; csS[w * 128 + j] = ex + v0; csS[w * 128 + j + 1] = s;
    if (csl_out && lane == 63) *csl_out = s;
}

constexpr int LD136 = 272;

__device__ __forceinline__ void ret1_tile(const Ctx& c, int item, LAS unsigned char* lds) {
    const int tid = otid(), w = tid >> 6, lane = tid & 63, fr = lane & 15, fq = lane >> 4;
    const int n = item & 15, h = (item >> 4) & 3, b = item >> 6;
    const int row0 = b * PL + n * 128;
    const float lg = __logf(1.f - exp2f(-5.f - (float)h));
    LAS bf16_t* Kt = (LAS bf16_t*)lds; LAS bf16_t* Vt = Kt + 128 * 136;
#pragma unroll
    for (int r = 0; r < 2; ++r) { const int unit = tid + 512 * r, dg = unit & 7, j = unit >> 3;
        const bf16_t* src = c.U + (size_t)(row0 + j) * NU + U_KR + h * 128 + dg * 8;
        const u32x4 lo = *(const u32x4*)src, hi = *(const u32x4*)(src + 64); float fl[8], fh[8]; UNPACK8(lo, fl); UNPACK8(hi, fh);
        const float pos = (float)(n * 128 + j), sc = 0.08838834764831845f * __expf(lg * (float)(127 - j));
#pragma unroll
        for (int e = 0; e < 8; ++e) { float cs, sn; rot_cs(pos, dg * 8 + e, cs, sn);
            Kt[(dg * 8 + e) * 136 + j] = (bf16_t)f2bf((fl[e] * cs - fh[e] * sn) * sc); Kt[(64 + dg * 8 + e) * 136 + j] = (bf16_t)f2bf((fl[e] * sn + fh[e] * cs) * sc); } }
#pragma unroll
    for (int r = 0; r < 4; ++r) { const int unit = tid + 512 * r, vg = unit & 15, j = unit >> 4;
        const u32x4 vv = *(const u32x4*)(c.U + (size_t)(row0 + j) * NU + U_VR + h * 128 + vg * 8);
        const unsigned q[4] = {vv.x, vv.y, vv.z, vv.w};
#pragma unroll
        for (int e = 0; e < 4; ++e) { Vt[(vg * 8 + 2 * e) * 136 + j] = (bf16_t)(q[e] & 0xffffu); Vt[(vg * 8 + 2 * e + 1) * 136 + j] = (bf16_t)(q[e] >> 16); } }
    __syncthreads();
    f32x4 acc[8];
#pragma unroll
    for (int i = 0; i < 8; ++i) acc[i] = (f32x4){0.f, 0.f, 0.f, 0.f};
    mm_strip<8, 4>(acc, (const LAS unsigned char*)Kt + w * 16 * LD136, LD136, (const LAS unsigned char*)Vt, LD136, fr, fq);
    float* dst = c.KV + ((size_t)((b * 4 + h) * 16 + n)) * 16384 + (16 * w + fr) * 128 + 4 * fq;
#pragma unroll
    for (int nb = 0; nb < 8; ++nb) *(f32x4*)(dst + 16 * nb) = acc[nb];
    __syncthreads();
}

__device__ __forceinline__ void ret2_tile(const Ctx& c, int item, LAS unsigned char* lds) {
    const int tid = otid(), w = tid >> 6, lane = tid & 63, fr = lane & 15, fq = lane >> 4;
    const int n = item & 15, h = (item >> 4) & 3, b = item >> 6;
    const int row0 = b * PL + n * 128;
    const float lg = __logf(1.f - exp2f(-5.f - (float)h));
    LAS bf16_t* Qs = (LAS bf16_t*)lds; LAS bf16_t* Ks = Qs + 128 * 136; LAS bf16_t* Vt = Ks + 128 * 136; LAS bf16_t* St = Vt + 128 * 136;
#pragma unroll
    for (int r = 0; r < 2; ++r) { const int unit = tid + 512 * r, dg = unit & 7, j = unit >> 3;
        const bf16_t* qsrc = c.U + (size_t)(row0 + j) * NU + U_QR + h * 128 + dg * 8; const bf16_t* ksrc = qsrc + (U_KR - U_QR);
        const u32x4 qlo = *(const u32x4*)qsrc, qhi = *(const u32x4*)(qsrc + 64), klo = *(const u32x4*)ksrc, khi = *(const u32x4*)(ksrc + 64);
        float ql[8], qh[8], kl[8], kh[8]; UNPACK8(qlo, ql); UNPACK8(qhi, qh); UNPACK8(klo, kl); UNPACK8(khi, kh);
        const float pos = (float)(n * 128 + j); float q1[8], q2[8], k1[8], k2[8];
#pragma unroll
        for (int e = 0; e < 8; ++e) { float cs, sn; rot_cs(pos, dg * 8 + e, cs, sn);
            q1[e] = ql[e] * cs - qh[e] * sn; q2[e] = ql[e] * sn + qh[e] * cs;
            k1[e] = (kl[e] * cs - kh[e] * sn) * 0.08838834764831845f; k2[e] = (kl[e] * sn + kh[e] * cs) * 0.08838834764831845f; }
        u32x4 o;
        o.x = pk2(q1[0], q1[1]); o.y = pk2(q1[2], q1[3]); o.z = pk2(q1[4], q1[5]); o.w = pk2(q1[6], q1[7]); *(LAS u32x4*)(Qs + j * 136 + dg * 8) = o;
        o.x = pk2(q2[0], q2[1]); o.y = pk2(q2[2], q2[3]); o.z = pk2(q2[4], q2[5]); o.w = pk2(q2[6], q2[7]); *(LAS u32x4*)(Qs + j * 136 + 64 + dg * 8) = o;
        o.x = pk2(k1[0], k1[1]); o.y = pk2(k1[2], k1[3]); o.z = pk2(k1[4], k1[5]); o.w = pk2(k1[6], k1[7]); *(LAS u32x4*)(Ks + j * 136 + dg * 8) = o;
        o.x = pk2(k2[0], k2[1]); o.y = pk2(k2[2], k2[3]); o.z = pk2(k2[4], k2[5]); o.w = pk2(k2[6], k2[7]); *(LAS u32x4*)(Ks + j * 136 + 64 + dg * 8) = o; }
#pragma unroll
    for (int r = 0; r < 4; ++r) { const int unit = tid + 512 * r, vg = unit & 15, j = unit >> 4;
        const u32x4 vv = *(const u32x4*)(c.U + (size_t)(row0 + j) * NU + U_VR + h * 128 + vg * 8);
        const unsigned q[4] = {vv.x, vv.y, vv.z, vv.w};
#pragma unroll
        for (int e = 0; e < 4; ++e) { Vt[(vg * 8 + 2 * e) * 136 + j] = (bf16_t)(q[e] & 0xffffu); Vt[(vg * 8 + 2 * e + 1) * 136 + j] = (bf16_t)(q[e] >> 16); } }
    { const float* sb = c.KV + ((size_t)((b * 4 + h) * 16 + n)) * 16384;
#pragma unroll
      for (int r = 0; r < 8; ++r) { const int unit = tid + 512 * r, vq = unit & 31, d = unit >> 5;
          const f32x4 sv = *(const f32x4*)(sb + d * 128 + vq * 4);
#pragma unroll
          for (int e = 0; e < 4; ++e) St[(vq * 4 + e) * 136 + d] = (bf16_t)f2bf(sv[e]); } }
    __syncthreads();
    f32x4 acc[8];
#pragma unroll
    for (int i = 0; i < 8; ++i) acc[i] = (f32x4){0.f, 0.f, 0.f, 0.f};
    mm_strip<8, 4>(acc, (const LAS unsigned char*)Qs + w * 16 * LD136, LD136, (const LAS unsigned char*)Ks, LD136, fr, fq);
    const int i = 16 * w + fr;
    __syncthreads();
#pragma unroll
    for (int nb = 0; nb < 8; ++nb) { float p[4];
#pragma unroll
        for (int e = 0; e < 4; ++e) { const int dl = i - (16 * nb + 4 * fq + e); p[e] = dl >= 0 ? acc[nb][e] * __expf(lg * (float)dl) : 0.f; }
        u32x2 o; o.x = pk2(p[0], p[1]); o.y = pk2(p[2], p[3]); *(LAS u32x2*)(Ks + i * 136 + 16 * nb + 4 * fq) = o; }
    f32x4 a2[8], a3[8];
#pragma unroll
    for (int k = 0; k < 8; ++k) { a2[k] = (f32x4){0.f, 0.f, 0.f, 0.f}; a3[k] = (f32x4){0.f, 0.f, 0.f, 0.f}; }
    mm_strip<8, 4>(a2, (const LAS unsigned char*)Ks + w * 16 * LD136, LD136, (const LAS unsigned char*)Vt, LD136, fr, fq);
    mm_strip<8, 4>(a3, (const LAS unsigned char*)Qs + w * 16 * LD136, LD136, (const LAS unsigned char*)St, LD136, fr, fq);
    const float qd = __expf(lg * (float)(i + 1)); float s = 0.f;
#pragma unroll
    for (int nb = 0; nb < 8; ++nb) { a2[nb] = a2[nb] + a3[nb] * qd; s += (a2[nb][0] + a2[nb][1]) + (a2[nb][2] + a2[nb][3]); }
    s += __shfl_xor(s, 16); s += __shfl_xor(s, 32);
    const float mean = s * (1.f / 128.f); float q = 0.f;
#pragma unroll
    for (int nb = 0; nb < 8; ++nb) { a2[nb] = a2[nb] - mean; q += (a2[nb][0] * a2[nb][0] + a2[nb][1] * a2[nb][1]) + (a2[nb][2] * a2[nb][2] + a2[nb][3] * a2[nb][3]); }
    q += __shfl_xor(q, 16); q += __shfl_xor(q, 32);
    const float rstd = rsqrtf(q * (1.f / 128.f) + EPS);
    const bf16_t* gp = c.U + (size_t)(row0 + i) * NU + U_GR + h * 128 + 4 * fq; bf16_t* op = c.ABR + (size_t)(row0 + i) * KBR + h * 128 + 4 * fq;
#pragma unroll
    for (int nb = 0; nb < 8; ++nb) { const u32x2 gv = *(const u32x2*)(gp + 16 * nb);
        const float g0 = siluf_(lo16(gv.x)), g1 = siluf_(hi16(gv.x)), g2 = siluf_(lo16(gv.y)), g3 = siluf_(hi16(gv.y));
        u32x2 o; o.x = pk2(a2[nb][0] * rstd * g0, a2[nb][1] * rstd * g1); o.y = pk2(a2[nb][2] * rstd * g2, a2[nb][3] * rstd * g3); *(u32x2*)(op + 16 * nb) = o; }
    __syncthreads();
}

__device__ __forceinline__ void ssd1_tile(const Ctx& c, int item, LAS unsigned char* lds) {
    const int tid = otid(), w = tid >> 6, lane = tid & 63, fr = lane & 15, fq = lane >> 4;
    const int g = item & 1, n = (item >> 1) & 15, b = item >> 5;
    const int row0 = b * PL + n * 128;
    LAS bf16_t* Bt = (LAS bf16_t*)lds; LAS bf16_t* Xt = Bt + 128 * 136; LAS float* dtS = (LAS float*)(Xt + 64 * 136); LAS float* csS = dtS + 1024;
    ssd_dtcs(c, row0, g, dtS, csS, w, lane, c.CSL + (b * 16 + n) * 16 + g * 8 + w);
#pragma unroll
    for (int r = 0; r < 4; ++r) { const int unit = tid + 512 * r, sg = unit & 15, j = unit >> 4; float o[8];
        conv8(c, row0 + j, n * 128 + j, 1024 + g * 128 + sg * 8, o);
#pragma unroll
        for (int e = 0; e < 8; ++e) Bt[(sg * 8 + e) * 136 + j] = (bf16_t)f2bf(o[e]); }
    __syncthreads();
    for (int hl = 0; hl < 8; ++hl) { const int h = g * 8 + hl;
        const float csl = csS[hl * 128 + 127];
#pragma unroll
        for (int r = 0; r < 2; ++r) { const int unit = tid + 512 * r, pg = unit & 7, j = unit >> 3; float o[8];
            conv8(c, row0 + j, n * 128 + j, h * 64 + pg * 8, o);
            const float sc = dtS[hl * 128 + j] * __expf(csl - csS[hl * 128 + j]);
#pragma unroll
            for (int e = 0; e < 8; ++e) Xt[(pg * 8 + e) * 136 + j] = (bf16_t)f2bf(o[e] * sc); }
        __syncthreads();
        const int strip = w & 3, nh = w >> 2;
        f32x4 acc[4];
#pragma unroll
        for (int k = 0; k < 4; ++k) acc[k] = (f32x4){0.f, 0.f, 0.f, 0.f};
        mm_strip<4, 4>(acc, (const LAS unsigned char*)Xt + strip * 16 * LD136, LD136, (const LAS unsigned char*)Bt + nh * 64 * LD136, LD136, fr, fq);
        float* dst = c.ST + ((size_t)(((b * 16 + n) * 16 + h) * 64 + 16 * strip + fr)) * 128 + nh * 64 + 4 * fq;
#pragma unroll
        for (int nb = 0; nb < 4; ++nb) *(f32x4*)(dst + 16 * nb) = acc[nb];
        __syncthreads();
    }
}

__device__ __forceinline__ void ssd2_tile(const Ctx& c, int item, LAS unsigned char* lds) {
    const int tid = otid(), w = tid >> 6, lane = tid & 63, fr = lane & 15, fq = lane >> 4;
    const int g = item & 1, n = (item >> 1) & 15, b = item >> 5;
    const int row0 = b * PL + n * 128;
    LAS bf16_t* Cs = (LAS bf16_t*)lds; LAS bf16_t* Bs = Cs + 128 * 136; LAS bf16_t* Xt = Bs + 128 * 136; LAS bf16_t* Ss = Xt + 64 * 136;
    LAS float* dtS = (LAS float*)(Ss + 64 * 136); LAS float* csS = dtS + 1024;
    ssd_dtcs(c, row0, g, dtS, csS, w, lane, nullptr);
#pragma unroll
    for (int r = 0; r < 4; ++r) { const int unit = tid + 512 * r, sg = unit & 15, j = unit >> 4; float o[8]; u32x4 pk;
        conv8(c, row0 + j, n * 128 + j, 1024 + g * 128 + sg * 8, o);
        pk.x = pk2(o[0], o[1]); pk.y = pk2(o[2], o[3]); pk.z = pk2(o[4], o[5]); pk.w = pk2(o[6], o[7]); *(LAS u32x4*)(Bs + j * 136 + sg * 8) = pk;
        conv8(c, row0 + j, n * 128 + j, 1280 + g * 128 + sg * 8, o);
        pk.x = pk2(o[0], o[1]); pk.y = pk2(o[2], o[3]); pk.z = pk2(o[4], o[5]); pk.w = pk2(o[6], o[7]); *(LAS u32x4*)(Cs + j * 136 + sg * 8) = pk; }
    __syncthreads();
    f32x4 cb[8];
#pragma unroll
    for (int k = 0; k < 8; ++k) cb[k] = (f32x4){0.f, 0.f, 0.f, 0.f};
    mm_strip<8, 4>(cb, (const LAS unsigned char*)Cs + w * 16 * LD136, LD136, (const LAS unsigned char*)Bs, LD136, fr, fq);
    __syncthreads();
    const int i = 16 * w + fr; float sumsq = 0.f;
    for (int hl = 0; hl < 8; ++hl) { const int h = g * 8 + hl;
#pragma unroll
        for (int r = 0; r < 2; ++r) { const int unit = tid + 512 * r, pg = unit & 7, j = unit >> 3; float o[8];
            conv8(c, row0 + j, n * 128 + j, h * 64 + pg * 8, o);
#pragma unroll
            for (int e = 0; e < 8; ++e) Xt[(pg * 8 + e) * 136 + j] = (bf16_t)f2bf(o[e]); }
        { const float* sb = c.ST + ((size_t)(((b * 16 + n) * 16 + h) * 64)) * 128;
#pragma unroll
          for (int r = 0; r < 2; ++r) { const int unit = tid + 512 * r, s8 = unit & 15, p = unit >> 4;
              const f32x4 v0 = *(const f32x4*)(sb + p * 128 + s8 * 8), v1 = *(const f32x4*)(sb + p * 128 + s8 * 8 + 4);
              u32x4 pk; pk.x = pk2(v0[0], v0[1]); pk.y = pk2(v0[2], v0[3]); pk.z = pk2(v1[0], v1[1]); pk.w = pk2(v1[2], v1[3]); *(LAS u32x4*)(Ss + p * 136 + s8 * 8) = pk; } }
        const float csi = csS[hl * 128 + i];
#pragma unroll
        for (int nb = 0; nb < 8; ++nb) { const f32x4 csj = *(const LAS f32x4*)(csS + hl * 128 + 16 * nb + 4 * fq), dtj = *(const LAS f32x4*)(dtS + hl * 128 + 16 * nb + 4 * fq); float p[4];
#pragma unroll
            for (int e = 0; e < 4; ++e) { const int j = 16 * nb + 4 * fq + e; p[e] = (i >= j) ? cb[nb][e] * __expf(csi - csj[e]) * dtj[e] : 0.f; }
            u32x2 o; o.x = pk2(p[0], p[1]); o.y = pk2(p[2], p[3]); *(LAS u32x2*)(Bs + i * 136 + 16 * nb + 4 * fq) = o; }
        __syncthreads();
        f32x4 yi[4], yc[4];
#pragma unroll
        for (int k = 0; k < 4; ++k) { yi[k] = (f32x4){0.f, 0.f, 0.f, 0.f}; yc[k] = (f32x4){0.f, 0.f, 0.f, 0.f}; }
        mm_strip<4, 4>(yi, (const LAS unsigned char*)Bs + w * 16 * LD136, LD136, (const LAS unsigned char*)Xt, LD136, fr, fq);
        mm_strip<4, 4>(yc, (const LAS unsigned char*)Cs + w * 16 * LD136, LD136, (const LAS unsigned char*)Ss, LD136, fr, fq);
        const float ecs = __expf(csi), dsk = c.in[12][c.l * 16 + h];
        const bf16_t* zp = c.U + (size_t)(row0 + i) * NU + U_Z + h * 64 + 4 * fq; bf16_t* op = c.ABR + (size_t)(row0 + i) * KBR + 512 + h * 64 + 4 * fq;
#pragma unroll
        for (int nb = 0; nb < 4; ++nb) { const u32x2 zv = *(const u32x2*)(zp + 16 * nb); const float zz[4] = {lo16(zv.x), hi16(zv.x), lo16(zv.y), hi16(zv.y)}; float y[4];
#pragma unroll
            for (int e = 0; e < 4; ++e) { const float xv = bf2f(Xt[(16 * nb + 4 * fq + e) * 136 + i]); y[e] = (yi[nb][e] + ecs * yc[nb][e] + dsk * xv) * siluf_(zz[e]); sumsq += y[e] * y[e]; }
            u32x2 o; o.x = pk2(y[0], y[1]); o.y = pk2(y[2], y[3]); *(u32x2*)(op + 16 * nb) = o; }
        __syncthreads();
    }
    sumsq += __shfl_xor(sumsq, 16); sumsq += __shfl_xor(sumsq, 32);
    if (fq == 0) c.RSTD[(row0 + i) * 2 + g] = rsqrtf(sumsq * (1.f / 512.f) + EPS);
}

__device__ __forceinline__ void swa_tile(const Ctx& c, int item, LAS unsigned char* lds) {
    const int tid = otid(), w = tid >> 6, lane = tid & 63, fr = lane & 15, fq = lane >> 4;
    const int kvh = item & 1, qb = (item >> 1) & 15, b = item >> 5;
    const int row0 = b * PL + qb * 128;
    LAS bf16_t* Ks = (LAS bf16_t*)lds; LAS bf16_t* Vt = Ks + 256 * 72; LAS bf16_t* Ps = Vt + 64 * 264; LAS float* biasT = (LAS float*)(Ps + 128 * 168);
#pragma unroll
    for (int r = 0; r < 4; ++r) { const int unit = tid + 512 * r, dg = unit & 7, jx = unit >> 3; const int kp = qb * 128 - 128 + jx;
        u32x4 kv = (u32x4){0u, 0u, 0u, 0u}, vv = (u32x4){0u, 0u, 0u, 0u};
        if (kp >= 0) { const bf16_t* src = c.U + (size_t)(b * PL + kp) * NU + U_KC + kvh * 64 + dg * 8; kv = *(const u32x4*)src; vv = *(const u32x4*)(src + (U_VC - U_KC)); }
        *(LAS u32x4*)(Ks + jx * 72 + dg * 8) = kv;
        const unsigned q[4] = {vv.x, vv.y, vv.z, vv.w};
#pragma unroll
        for (int e = 0; e < 4; ++e) { Vt[(dg * 8 + 2 * e) * 264 + jx] = (bf16_t)(q[e] & 0xffffu); Vt[(dg * 8 + 2 * e + 1) * 264 + jx] = (bf16_t)(q[e] >> 16); } }
    for (int idx = tid; idx < 4 * 129; idx += 512) { const int gq = idx / 129, d = idx % 129; biasT[gq * 132 + d] = c.in[15][T5_BUCKET[d] * 8 + kvh * 4 + gq]; }
    __syncthreads();
    const int jstart = (16 * w < 96) ? 16 * w : 96;
    const int i = 16 * w + fr;
    for (int gq = 0; gq < 4; ++gq) { const int hq = kvh * 4 + gq;
        const bf16_t* qrow = c.U + (size_t)(row0 + i) * NU + U_QC + hq * 64;
        const bf16x8 qa0 = *(const bf16x8*)(qrow + fq * 8), qa1 = *(const bf16x8*)(qrow + 32 + fq * 8);
        f32x4 acc[10];
#pragma unroll
        for (int nb = 0; nb < 10; ++nb) { acc[nb] = (f32x4){0.f, 0.f, 0.f, 0.f};
            const LAS bf16_t* kr = Ks + (jstart + 16 * nb + fr) * 72 + fq * 8;
            acc[nb] = __builtin_amdgcn_mfma_f32_16x16x32_bf16(*(const LAS bf16x8*)kr, qa0, acc[nb], 0, 0, 0);
            acc[nb] = __builtin_amdgcn_mfma_f32_16x16x32_bf16(*(const LAS bf16x8*)(kr + 32), qa1, acc[nb], 0, 0, 0); }
        const float sink = c.in[14][c.l * 8 + hq]; float m = sink;
#pragma unroll
        for (int nb = 0; nb < 10; ++nb)
#pragma unroll
            for (int e = 0; e < 4; ++e) { const int jx = jstart + 16 * nb + 4 * fq + e, dist = i + 128 - jx; const bool ok = dist >= 0 && dist <= 128 && (qb > 0 || jx >= 128);
                const int dc = dist < 0 ? 0 : (dist > 128 ? 128 : dist);
                const float lgt = ok ? acc[nb][e] * 0.125f + biasT[gq * 132 + dc] : -1e30f; acc[nb][e] = lgt; m = fmaxf(m, lgt); }
        m = fmaxf(m, __shfl_xor(m, 16)); m = fmaxf(m, __shfl_xor(m, 32));
        float s = 0.f;
#pragma unroll
        for (int nb = 0; nb < 10; ++nb)
#pragma unroll
            for (int e = 0; e < 4; ++e) { const float p = acc[nb][e] > -1e29f ? __expf(acc[nb][e] - m) : 0.f; acc[nb][e] = p; s += p; }
        s += __shfl_xor(s, 16); s += __shfl_xor(s, 32);
        const float inv = 1.f / (s + __expf(sink - m));
#pragma unroll
        for (int nb = 0; nb < 10; ++nb) { u32x2 o; o.x = pk2(acc[nb][0] * inv, acc[nb][1] * inv); o.y = pk2(acc[nb][2] * inv, acc[nb][3] * inv); *(LAS u32x2*)(Ps + i * 168 + 16 * nb + 4 * fq) = o; }
        f32x4 oa[4];
#pragma unroll
        for (int k = 0; k < 4; ++k) oa[k] = (f32x4){0.f, 0.f, 0.f, 0.f};
#pragma unroll
        for (int ks = 0; ks < 5; ++ks) { const bf16x8 a = *(const LAS bf16x8*)(Ps + i * 168 + ks * 32 + fq * 8);
#pragma unroll
            for (int nb = 0; nb < 4; ++nb) { const bf16x8 bb = *(const LAS bf16x8*)(Vt + (16 * nb + fr) * 264 + jstart + ks * 32 + fq * 8); oa[nb] = __builtin_amdgcn_mfma_f32_16x16x32_bf16(bb, a, oa[nb], 0, 0, 0); } }
        bf16_t* op = c.ABR + (size_t)(row0 + i) * KBR + 1536 + hq * 64 + 4 * fq;
#pragma unroll
        for (int nb = 0; nb < 4; ++nb) { u32x2 o; o.x = pk2(oa[nb][0], oa[nb][1]); o.y = pk2(oa[nb][2], oa[nb][3]); *(u32x2*)(op + 16 * nb) = o; }
    }
    __syncthreads();
}

__device__ __forceinline__ void copyp_tile(const Ctx& c, int b) {
    const int tid = otid();
    for (int idx = tid; idx < 3 * 1536; idx += 512) { const int r = idx / 1536, ch = idx % 1536;
        c.out[O_CONVP + ((size_t)(c.l * 8 + b) * 3 + r) * 1536 + ch] = bf2f(c.U[(size_t)(b * PL + PL - 3 + r) * NU + U_XBC + ch]); }
    for (int idx = tid; idx < 128 * 128; idx += 512) { const int j = idx >> 7, ch = idx & 127; const size_t ur = (size_t)(b * PL + PL - 128 + j) * NU;
        c.out[O_KP + ((size_t)(c.l * 8 + b) * 128 + j) * 128 + ch] = bf2f(c.U[ur + U_KC + ch]);
        c.out[O_VP + ((size_t)(c.l * 8 + b) * 128 + j) * 128 + ch] = bf2f(c.U[ur + U_VC + ch]); }
}

__device__ __forceinline__ void sret_tile(const Ctx& c, int item, LAS unsigned char* lds) {
    const int tid = otid(), w = tid >> 6;
    const int h = item & 3, b = item >> 2, row = MPR + b;
    LAS float* qS = (LAS float*)lds; LAS float* kS = qS + 128; LAS float* vS = kS + 128; LAS float* part = vS + 128; LAS float* red = part + 512;
    const bf16_t* ur = c.U + (size_t)row * NU;
    if (tid < 64) { float cs, sn; rot_cs(PAST_POS, tid, cs, sn);
        const float ql = bf2f(ur[U_QR + h * 128 + tid]), qh = bf2f(ur[U_QR + h * 128 + 64 + tid]), kl = bf2f(ur[U_KR + h * 128 + tid]), kh = bf2f(ur[U_KR + h * 128 + 64 + tid]);
        qS[tid] = ql * cs - qh * sn; qS[64 + tid] = ql * sn + qh * cs; kS[tid] = (kl * cs - kh * sn) * 0.08838834764831845f; kS[64 + tid] = (kl * sn + kh * cs) * 0.08838834764831845f;
    } else if (tid < 192) vS[tid - 64] = bf2f(ur[U_VR + h * 128 + tid - 64]);
    __syncthreads();
    const int v = tid & 127, dq = tid >> 7; const float gamma = 1.f - exp2f(-5.f - (float)h), vv = vS[v];
    const size_t base = ((size_t)(c.l * 128 + b) * 4 + h) * 16384; const float* sin_ = c.in[2] + base; float* sout = c.out + O_RETS + base;
    float o = 0.f;
#pragma unroll 8
    for (int dd = 0; dd < 32; ++dd) { const int d = dq * 32 + dd; const float sn = gamma * sin_[d * 128 + v] + kS[d] * vv; sout[d * 128 + v] = sn; o += qS[d] * sn; }
    part[dq * 128 + v] = o;
    __syncthreads();
    float ov = 0.f;
    if (tid < 128) { ov = part[tid] + part[128 + tid] + part[256 + tid] + part[384 + tid]; const float s = wave_sum(ov); if ((tid & 63) == 0) red[w] = s; }
    __syncthreads();
    const float mean = (red[0] + red[1]) * (1.f / 128.f); const float dv = ov - mean;
    if (tid < 128) { const float s = wave_sum(dv * dv); if ((tid & 63) == 0) red[2 + w] = s; }
    __syncthreads();
    if (tid < 128) { const float rstd = rsqrtf((red[2] + red[3]) * (1.f / 128.f) + EPS); const float gt = siluf_(bf2f(ur[U_GR + h * 128 + tid]));
        c.ABR[(size_t)row * KBR + h * 128 + tid] = (bf16_t)f2bf(dv * rstd * gt); }
    __syncthreads();
}

__device__ __forceinline__ void sssd_tile(const Ctx& c, int item, LAS unsigned char* lds) {
    const int tid = otid();
    const int g = item & 1, b = item >> 1, row = MPR + b;
    LAS float* xS = (LAS float*)lds; LAS float* BS = xS + 512; LAS float* CS = BS + 128; LAS float* dtv = CS + 128; LAS float* ysq = dtv + 8; LAS float* prod = ysq + 512;
    const bf16_t* ur = c.U + (size_t)row * NU;
    for (int ch = tid; ch < 768; ch += 512) { const int cb = ch < 512 ? g * 512 + ch : (ch < 640 ? 1024 + g * 128 + (ch - 512) : 1280 + g * 128 + (ch - 640));
        const float* cw = c.in[8] + (size_t)c.l * 4 * 1536 + cb; const float* sc = c.in[4] + (size_t)(c.l * 128 + b) * 3 * 1536 + cb;
        float a = c.in[9][c.l * 1536 + cb] + cw[0] * sc[0] + cw[1536] * sc[1536] + cw[3072] * sc[3072] + cw[4608] * bf2f(ur[U_XBC + cb]);
        xS[ch] = siluf_(a); }
    if (tid < 8) dtv[tid] = softplusf_(bf2f(ur[U_DT + g * 8 + tid]) + c.in[10][c.l * 16 + g * 8 + tid]);
    __syncthreads();
    const int s = tid & 127, pq = tid >> 7;
    for (int hl = 0; hl < 8; ++hl) { const int h = g * 8 + hl; const float dt = dtv[hl], dA = __expf(dt * -__expf(c.in[11][c.l * 16 + h]));
        const size_t base = ((size_t)(c.l * 128 + b) * 16 + h) * 8192; const float* hin = c.in[3] + base; float* hout = c.out + O_SSMS + base;
        const float bs = BS[s] * dt, cv = CS[s];
#pragma unroll 8
        for (int pp = 0; pp < 16; ++pp) { const int p = pq * 16 + pp; const float hn = dA * hin[p * 128 + s] + xS[hl * 64 + p] * bs; hout[p * 128 + s] = hn; prod[p * 129 + s] = hn * cv; }
        __syncthreads();
        { const int p = tid >> 3, sub = tid & 7; float a = 0.f;
#pragma unroll
          for (int k = 0; k < 16; ++k) a += prod[p * 129 + sub * 16 + k];
          a += __shfl_xor(a, 1); a += __shfl_xor(a, 2); a += __shfl_xor(a, 4);
          if (sub == 0) { float y = a + c.in[12][c.l * 16 + h] * xS[hl * 64 + p]; y *= siluf_(bf2f(ur[U_Z + h * 64 + p])); c.ABR[(size_t)row * KBR + 512 + h * 64 + p] = (bf16_t)f2bf(y); ysq[hl * 64 + p] = y * y; } }
        __syncthreads();
    }
    if (tid < 64) { float a = 0.f;
#pragma unroll
        for (int k = 0; k < 8; ++k) a += ysq[tid * 8 + k];
        a = wave_sum(a); if (tid == 0) c.RSTD[row * 2 + g] = rsqrtf(a * (1.f / 512.f) + EPS); }
    __syncthreads();
}

__device__ __forceinline__ void sswa_tile(const Ctx& c, int b, LAS unsigned char* lds) {
    const int tid = otid(), w = tid >> 6, lane = tid & 63, row = MPR + b;
    LAS float* qS = (LAS float*)lds; LAS float* knew = qS + 512; LAS float* vnew = knew + 128; LAS float* pS = vnew + 128;
    const bf16_t* ur = c.U + (size_t)row * NU;
    qS[tid] = bf2f(ur[U_QC + tid]);
    if (tid < 128) knew[tid] = bf2f(ur[U_KC + tid]); else if (tid < 256) vnew[tid - 128] = bf2f(ur[U_VC + tid - 128]);
    __syncthreads();
    const int hq = w, kvh = w >> 2;
    const float* kc = c.in[5] + (size_t)(c.l * 128 + b) * 128 * 128 + kvh * 64; const float* vc = c.in[6] + (size_t)(c.l * 128 + b) * 128 * 128 + kvh * 64;
    float d0 = 0.f, d1 = 0.f, dn = 0.f;
#pragma unroll 4
    for (int d4 = 0; d4 < 16; ++d4) { const f32x4 q = *(const LAS f32x4*)(qS + hq * 64 + d4 * 4), k0 = *(const f32x4*)(kc + (size_t)lane * 128 + d4 * 4), k1 = *(const f32x4*)(kc + (size_t)(lane + 64) * 128 + d4 * 4), kn = *(const LAS f32x4*)(knew + kvh * 64 + d4 * 4);
        d0 += q[0] * k0[0] + q[1] * k0[1] + q[2] * k0[2] + q[3] * k0[3]; d1 += q[0] * k1[0] + q[1] * k1[1] + q[2] * k1[2] + q[3] * k1[3]; dn += q[0] * kn[0] + q[1] * kn[1] + q[2] * kn[2] + q[3] * kn[3]; }
    const float* rb = c.in[15];
    const float l0 = d0 * 0.125f + rb[T5_BUCKET[128 - lane] * 8 + hq], l1 = d1 * 0.125f + rb[T5_BUCKET[64 - lane] * 8 + hq], ln = dn * 0.125f + rb[hq], sink = c.in[14][c.l * 8 + hq];
    const float m = fmaxf(fmaxf(wave_max(fmaxf(l0, l1)), ln), sink);
    const float p0 = __expf(l0 - m), p1 = __expf(l1 - m), pn = __expf(ln - m);
    const float inv = 1.f / (wave_sum(p0 + p1) + pn + __expf(sink - m));
    pS[hq * 132 + lane] = p0 * inv; pS[hq * 132 + 64 + lane] = p1 * inv; if (lane == 0) pS[hq * 132 + 128] = pn * inv;
    __syncthreads();
    float o = pS[hq * 132 + 128] * vnew[kvh * 64 + lane];
#pragma unroll 8
    for (int j = 0; j < 128; ++j) o += pS[hq * 132 + j] * vc[(size_t)j * 128 + lane];
    c.ABR[(size_t)row * KBR + 1536 + hq * 64 + lane] = (bf16_t)f2bf(o);
    const size_t sb = (size_t)(c.l * 128 + b) * 128 * 128; const float* kin = c.in[5] + sb; const float* vin = c.in[6] + sb;
    for (int idx = tid; idx < 128 * 128; idx += 512) { const int j = idx >> 7, ch = idx & 127;
        c.out[O_KS + sb + idx] = j < 127 ? kin[idx + 128] : knew[ch]; c.out[O_VS + sb + idx] = j < 127 ? vin[idx + 128] : vnew[ch]; }
    const size_t cbs = (size_t)(c.l * 128 + b) * 3 * 1536;
    for (int ch = tid; ch < 1536; ch += 512) { c.out[O_CONVS + cbs + ch] = c.in[4][cbs + 1536 + ch]; c.out[O_CONVS + cbs + 1536 + ch] = c.in[4][cbs + 3072 + ch]; c.out[O_CONVS + cbs + 3072 + ch] = bf2f(ur[U_XBC + ch]); }
    __syncthreads();
}

__device__ __forceinline__ void scan_phase(const Ctx& c) {
    const int gt = blockIdx.x * 512 + otid(), NT = gridDim.x * 512;
    for (int i = gt; i < 8 * 4 * 4096; i += NT) { const int e4 = i & 4095, bh = i >> 12, h = bh & 3;
        const float cdec = __expf(__logf(1.f - exp2f(-5.f - (float)h)) * 128.f);
        float* p = c.KV + (size_t)bh * 16 * 16384 + e4 * 4; f32x4 run = (f32x4){0.f, 0.f, 0.f, 0.f};
#pragma unroll 4
        for (int n = 0; n < 16; ++n) { const f32x4 t = *(const f32x4*)(p + n * 16384); *(f32x4*)(p + n * 16384) = run; run = run * cdec + t; }
        *(f32x4*)(c.out + O_RETP + ((size_t)c.l * 32 + bh) * 16384 + e4 * 4) = run; }
    for (int i = gt; i < 8 * 16 * 2048; i += NT) { const int e4 = i & 2047, bh = i >> 11, h = bh & 15, b = bh >> 4;
        f32x4 run = (f32x4){0.f, 0.f, 0.f, 0.f};
#pragma unroll 4
        for (int n = 0; n < 16; ++n) { float* p = c.ST + ((size_t)((b * 16 + n) * 16 + h)) * 8192 + e4 * 4; const float dec = __expf(c.CSL[(b * 16 + n) * 16 + h]);
            const f32x4 t = *(const f32x4*)p; *(f32x4*)p = run; run = run * dec + t; }
        *(f32x4*)(c.out + O_SSMP + ((size_t)c.l * 128 + bh) * 8192 + e4 * 4) = run; }
}

#define XB_TMO      128
#define XB_XCNT(j)  (256  + 64 * (j))
#define XB_XSUB(j)  (1280 + 64 * (j))
#define XB_XGEN(j)  (2304 + 64 * (j))
#define XB_TOP      3328
#define XB_TOPGEN   3392
#define XCD_BAR_WORDS 3456
#define XB_SPIN_CAP (1u << 22)
__device__ __forceinline__ unsigned xb_ld(unsigned* p)              { return __hip_atomic_load(p, __ATOMIC_RELAXED, __HIP_MEMORY_SCOPE_AGENT); }
__device__ __forceinline__ unsigned xb_add(unsigned* p, unsigned v) { return __hip_atomic_fetch_add(p, v, __ATOMIC_RELAXED, __HIP_MEMORY_SCOPE_AGENT); }
__device__ __forceinline__ unsigned xb_xcc_id() { return (unsigned)__builtin_amdgcn_s_getreg((3 << 11) | 20) & 0xFu; }
#define XB_SPIN(cond, bar) do { unsigned _sp = 0; while (cond) { __builtin_amdgcn_s_sleep(1); \
    if ((++_sp & 255u) == 0u) { if (xb_ld(&(bar)[XB_TMO])) break; if (_sp > XB_SPIN_CAP) { atomicAdd(&(bar)[XB_TMO], 1u); break; } } } } while (0)
struct XcdBarrier { unsigned* bar; unsigned x; volatile LAS unsigned* st; };
__device__ __forceinline__ XcdBarrier xcd_barrier_post(unsigned* bar, volatile LAS unsigned* st) {
    XcdBarrier b; b.bar = bar; b.x = xb_xcc_id(); b.st = st;
    if (threadIdx.x == 0) (void)xb_add(&bar[XB_XCNT(b.x)], 1u);
    return b;
}
__device__ __forceinline__ void xcd_barrier_complete(unsigned* bar, unsigned x, unsigned& nloc, unsigned& nx) {
    const unsigned G = gridDim.x * gridDim.y * gridDim.z;
    unsigned sum, cnt, mine, sp = 0u;
    for (;;) {
        sum = 0u; cnt = 0u; mine = 0u;
#pragma unroll
        for (unsigned j = 0; j < 16; ++j) { const unsigned c = xb_ld(&bar[XB_XCNT(j)]); sum += c; cnt += (c > 0u) ? 1u : 0u; mine = (j == x) ? c : mine; }
        if (sum == G) break;
        __builtin_amdgcn_s_sleep(1);
        if ((++sp & 255u) == 0u) { if (xb_ld(&bar[XB_TMO])) break; if (sp > XB_SPIN_CAP) { atomicAdd(&bar[XB_TMO], 1u); break; } }
    }
    nloc = mine > 0u ? mine : 1u; nx = cnt > 0u ? cnt : 1u;
}
__device__ __forceinline__ void xcd_barrier(const XcdBarrier& b) {
    asm volatile("s_waitcnt vmcnt(0)" ::: "memory");
    __syncthreads();
    if (threadIdx.x == 0) {
        unsigned* bar = b.bar;
        __builtin_amdgcn_s_waitcnt(0);
        unsigned nloc = b.st[0], nx = b.st[1];
        if (nloc == 0u) { xcd_barrier_complete(bar, b.x, nloc, nx); b.st[0] = nloc; b.st[1] = nx; }
        const unsigned old = xb_add(&bar[XB_XSUB(b.x)], 1u);
        const unsigned gen = old / nloc;
        if (old + 1u == (gen + 1u) * nloc) {
            __builtin_amdgcn_fence(__ATOMIC_RELEASE, "agent");
            asm volatile("s_waitcnt vmcnt(0)" ::: "memory");
            const unsigned og = xb_add(&bar[XB_TOP], 1u);
            const unsigned tg = og / nx;
            if (og + 1u == (tg + 1u) * nx) xb_add(&bar[XB_TOPGEN], 1u);
            else XB_SPIN(xb_ld(&bar[XB_TOPGEN]) == tg, bar);
            __builtin_amdgcn_fence(__ATOMIC_ACQUIRE, "agent");
            xb_add(&bar[XB_XGEN(b.x)], 1u);
            asm volatile("s_waitcnt vmcnt(0)" ::: "memory");
        } else {
            XB_SPIN(xb_ld(&bar[XB_XGEN(b.x)]) == gen, bar);
            __builtin_amdgcn_fence(__ATOMIC_ACQUIRE, "agent");
            asm volatile("s_waitcnt vmcnt(0)" ::: "memory");
        }
    }
    __syncthreads();
}

constexpr int N_PHASES = 1 + NLAYER * 10;
#ifndef DISMASK
#define DISMASK 0
#endif
#ifndef REPMASK
#define REPMASK 0
#endif
#define DIS(bit, stmt) do { if (!((DISMASK) & (bit))) { stmt; } } while (0)
__global__ void __launch_bounds__(512, 2) mega_fwd(Args a) {
    extern __shared__ __attribute__((aligned(16))) unsigned char lds_raw[];
    LAS unsigned char* lds = (LAS unsigned char*)lds_raw;
    cg::grid_group grid = cg::this_grid();
    Ctx c; c.in = a.in; c.out = a.out; c.ws = a.ws;
    c.XB = (bf16_t*)(a.ws + WS_XB); c.XF = (float*)(a.ws + WS_XF); c.U = (bf16_t*)(a.ws + WS_U); c.H = (bf16_t*)(a.ws + WS_U); c.ABR = (bf16_t*)(a.ws + WS_ABR);
    c.MIX = (float*)(a.ws + WS_MIX); c.MIXB = (bf16_t*)(a.ws + WS_MIXB); c.KV = (float*)(a.ws + WS_KV); c.ST = (float*)(a.ws + WS_ST); c.CSL = (float*)(a.ws + WS_CSL); c.RSTD = (float*)(a.ws + WS_RSTD);
    const int G = gridDim.x, bx = blockIdx.x;
    volatile LAS unsigned* bst = (volatile LAS unsigned*)(lds + LDS_BYTES - 16);
    if (threadIdx.x < 4) bst[threadIdx.x] = 0u;
    __syncthreads();
    XcdBarrier xbar = xcd_barrier_post((unsigned*)(a.ws + WS_CTL), bst);
    int rep = 0;
    for (int ph = a.ph_lo; ph < a.ph_hi; ++ph) {
        if (ph == 0) { c.l = 0; DIS(1024, prologue(c, lds)); }
        else {
            const int l = (ph - 1) / 10, s = (ph - 1) % 10; c.l = l;
            if (s == 0) {
                pg8::Gemm g{c.XB, wl(a.ws, l, OFF_WIN), MP, NU, DM, DM, DM}; pg8::StaticOrder S; S.init(MP, NU, G, bx);
                EpiBf16 E{c.U, NU}; DIS(2048, (pg8::gemm_phase<EpiBf16, true>(lds, g, S, E)));
            } else if (s == 1) {
                for (int it = bx; it < 1928; it += G) {
                    if (it < 256) { DIS(1, swa_tile(c, it, lds)); }
                    else if (it < 512) { DIS(2, ssd1_tile(c, it - 256, lds)); }
                    else if (it < 1024) { DIS(4, ret1_tile(c, it - 512, lds)); }
                    else if (it < 1536) { DIS(8, sret_tile(c, it - 1024, lds)); }
                    else if (it < 1792) { DIS(16, sssd_tile(c, it - 1536, lds)); }
                    else if (it < 1920) { DIS(32, sswa_tile(c, it - 1792, lds)); }
                    else { DIS(64, copyp_tile(c, it - 1920)); }
                }
            } else if (s == 2) { DIS(512, scan_phase(c)); }
            else if (s == 3) {
                for (int it = bx; it < 768; it += G) { if (it < 256) { DIS(128, ssd2_tile(c, it, lds)); } else { DIS(256, ret2_tile(c, it - 256, lds)); } }
            } else if (s == 4) {
                for (int br = 0; br < 4; ++br) {
                    pg8::Gemm g{c.ABR + br * 512, wl(a.ws, l, OFF_WBR) + br * 512, MP, DM, 512, KBR, KBR}; pg8::StaticOrder S; S.init(MP, DM, G, bx);
                    EpiBranch E{c.U, c.RSTD, c.MIX, c.MIXB, br}; DIS(4096, (pg8::gemm_phase<EpiBranch, true>(lds, g, S, E)));
                }
            } else if (s == 5 || s == 8) {
                pg8::Gemm g{s == 5 ? c.MIXB : c.H, wl(a.ws, l, s == 5 ? OFF_WOUT : OFF_WDN), MP, DM, s == 5 ? DM : DFF, s == 5 ? DM : DFF, s == 5 ? DM : DFF}; pg8::StaticOrder S; S.init(MP, DM, G, bx);
                EpiRes E{c.XF, c.MIX}; DIS(8192, (pg8::gemm_phase<EpiRes, true>(lds, g, S, E)));
            } else if (s == 6 || s == 9) {
                const bool fin = (s == 9 && l == NLAYER - 1);
                DIS(32768, ln_phase(c, c.in[s == 6 ? 20 : 22] + l * DM, c.in[s == 6 ? 21 : 23] + l * DM, fin));
            } else {
                pg8::Gemm g{c.XB, wl(a.ws, l, OFF_WGU), MP, 2 * DFF, DM, DM, DM}; pg8::StaticOrder S; S.init(MP, 2 * DFF, G, bx);
                EpiGU E{c.H}; DIS(16384, (pg8::gemm_phase<EpiGU, true>(lds, g, S, E)));
            }
        }
        if (ph + 1 < a.ph_hi) { if (ph == 0 && rep == 0) grid.sync(); else xcd_barrier(xbar); }
        if (REPMASK) { const int sidx = ph == 0 ? 10 : (ph - 1) % 10; if (((REPMASK) >> sidx & 1) && rep == 0) { rep = 1; --ph; } else rep = 0; }
    }
}

#ifndef MK_PER_PHASE
#define MK_PER_PHASE 0
#endif
extern "C" void kernel_launch(void* const* d_in, const int* in_sizes, int n_in, void* d_out, int out_size, void* d_ws, size_t ws_size, hipStream_t stream) {
    static int grid = 0;
    if (grid == 0) {
        if (n_in != 27 || (size_t)out_size != O_END || ws_size < WS_END) { fprintf(stderr, "kernel_launch: unexpected shapes: n_in %d out %d (want %zu) ws %zu (want %zu)\n", n_in, out_size, (size_t)O_END, ws_size, (size_t)WS_END); grid = -1; return; }
        int dev = 0, cus = 0, per_cu = 0;
        (void)hipGetDevice(&dev); (void)hipDeviceGetAttribute(&cus, hipDeviceAttributeMultiprocessorCount, dev);
        if (hipFuncSetAttribute((const void*)mega_fwd, hipFuncAttributeMaxDynamicSharedMemorySize, LDS_BYTES) != hipSuccess) { fprintf(stderr, "kernel_launch: hipFuncSetAttribute failed\n"); grid = -1; return; }
        if (hipOccupancyMaxActiveBlocksPerMultiprocessor(&per_cu, (const void*)mega_fwd, 512, LDS_BYTES) != hipSuccess || per_cu < 1) { fprintf(stderr, "kernel_launch: occupancy query says %d\n", per_cu); per_cu = 1; }
        (void)hipGetLastError();
        grid = cus * per_cu;
    }
    if (grid < 0) return;
    if (hipMemsetAsync((char*)d_ws + WS_CTL, 0, CTL_BYTES, stream) != hipSuccess) { fprintf(stderr, "kernel_launch: memset failed\n"); return; }
    Args a{};
    for (int i = 0; i < 27; ++i) a.in[i] = (const float*)d_in[i];
    a.out = (float*)d_out; a.ws = (unsigned char*)d_ws;
#if MK_PER_PHASE
    for (int ph = 0; ph < N_PHASES; ++ph) { a.ph_lo = ph; a.ph_hi = ph + 1; hipLaunchKernelGGL(mega_fwd, dim3(grid), dim3(512), LDS_BYTES, stream, a); }
#else
    a.ph_lo = 0; a.ph_hi = N_PHASES;
    void* args[] = {&a};
    hipError_t e = hipLaunchCooperativeKernel((const void*)mega_fwd, dim3(grid), dim3(512), args, LDS_BYTES, stream);
    if (e != hipSuccess) fprintf(stderr, "cooperative launch failed: %s (grid %d)\n", hipGetErrorString(e), grid);
#endif
}
```

```cpp
#include <hip/hip_runtime.h>
#include <hip/hip_cooperative_groups.h>
#include <cstdio>
#include <cstdint>
namespace cg = cooperative_groups;

#define LAS __attribute__((address_space(3)))
typedef unsigned short bf16_t;
typedef short bf16x8 __attribute__((ext_vector_type(8)));
typedef float f32x4 __attribute__((ext_vector_type(4)));
typedef float f32x2 __attribute__((ext_vector_type(2)));
typedef unsigned u32x4 __attribute__((ext_vector_type(4)));
typedef unsigned u32x2 __attribute__((ext_vector_type(2)));

constexpr int DM = 1024, NLAYER = 4;
constexpr int PB = 8, PL = 2048, MPR = PB * PL;
constexpr int SB = 128;
constexpr int MREAL = MPR + SB;
constexpr int MP = 16640;
constexpr int NIN = 8464, NU = 8704;
constexpr int DFF = 2816;
constexpr int KBR = 2048;
constexpr int U_QR = 0, U_KR = 512, U_VR = 1024, U_GR = 1536, U_Z = 2048, U_XBC = 3072, U_QC = 4608, U_KC = 5120, U_VC = 5248, U_GATE = 5376, U_DT = 8448;
constexpr float ALPHA = 1.681792830507429f;
constexpr float EPS = 1e-5f;
constexpr float PAST_POS = 8192.f;

constexpr size_t SZ_WIN = (size_t)NU * DM * 2, SZ_WBR = (size_t)DM * KBR * 2, SZ_WOUT = (size_t)DM * DM * 2, SZ_WGU = (size_t)2 * DFF * DM * 2, SZ_WDN = (size_t)DM * DFF * 2;
constexpr size_t SZ_WL = SZ_WIN + SZ_WBR + SZ_WOUT + SZ_WGU + SZ_WDN;
constexpr size_t WS_W = 0;
constexpr size_t WS_XB = WS_W + NLAYER * SZ_WL;
constexpr size_t WS_XF = WS_XB + (size_t)MP * DM * 2;
constexpr size_t WS_U = WS_XF + (size_t)MP * DM * 4;
constexpr size_t WS_ABR = WS_U + (size_t)MP * NU * 2;
constexpr size_t WS_MIX = WS_ABR + (size_t)MP * KBR * 2;
constexpr size_t WS_MIXB = WS_MIX + (size_t)MP * DM * 4;
constexpr size_t WS_KV = WS_MIXB + (size_t)MP * DM * 2;
constexpr size_t WS_ST = WS_KV + (size_t)8 * 4 * 16 * 16384 * 4;
constexpr size_t WS_CSL = WS_ST + (size_t)8 * 16 * 16 * 8192 * 4;
constexpr size_t WS_RSTD = WS_CSL + 8192;
constexpr size_t WS_XBCC = WS_RSTD + (size_t)MP * 2 * 4;
constexpr size_t WS_CTL = WS_XBCC + (size_t)MPR * 1536 * 2;
constexpr size_t CTL_BYTES = 16384;
constexpr size_t WS_END = WS_CTL + CTL_BYTES;

constexpr size_t O_Y = 0;
constexpr size_t O_RETP = (size_t)MREAL * DM;
constexpr size_t O_SSMP = O_RETP + (size_t)4 * 8 * 4 * 16384;
constexpr size_t O_CONVP = O_SSMP + (size_t)4 * 8 * 16 * 8192;
constexpr size_t O_KP = O_CONVP + (size_t)4 * 8 * 3 * 1536;
constexpr size_t O_VP = O_KP + (size_t)4 * 8 * 128 * 128;
constexpr size_t O_RETS = O_VP + (size_t)4 * 8 * 128 * 128;
constexpr size_t O_SSMS = O_RETS + (size_t)4 * 128 * 4 * 16384;
constexpr size_t O_CONVS = O_SSMS + (size_t)4 * 128 * 16 * 8192;
constexpr size_t O_KS = O_CONVS + (size_t)4 * 128 * 3 * 1536;
constexpr size_t O_VS = O_KS + (size_t)4 * 128 * 128 * 128;
constexpr size_t O_END = O_VS + (size_t)4 * 128 * 128 * 128;

constexpr int LDS_BYTES = 147456;

__device__ const unsigned char T5_BUCKET[132] = {0, 1, 2, 3, 4, 5, 6, 7, 8, 9, 10, 11, 12, 13, 14, 15, 16, 16, 16, 17, 17, 18, 18, 18, 19, 19, 19, 20, 20, 20, 20, 21, 21, 21, 21, 22, 22, 22, 22, 22, 23, 23, 23, 23, 23, 23, 24, 24, 24, 24, 24, 24, 25, 25, 25, 25, 25, 25, 25, 26, 26, 26, 26, 26, 26, 26, 26, 27, 27, 27, 27, 27, 27, 27, 27, 27, 27, 28, 28, 28, 28, 28, 28, 28, 28, 28, 28, 29, 29, 29, 29, 29, 29, 29, 29, 29, 29, 29, 29, 30, 30, 30, 30, 30, 30, 30, 30, 30, 30, 30, 30, 30, 30, 31, 31, 31, 31, 31, 31, 31, 31, 31, 31, 31, 31, 31, 31, 31, 31, 31, 31, 31};

__device__ __forceinline__ int otid() { int t = threadIdx.x; asm volatile("" : "+v"(t)); return t; }
__device__ __forceinline__ float bf2f(unsigned short h) { return __uint_as_float(((unsigned)h) << 16); }
__device__ __forceinline__ unsigned f2bf(float f) { unsigned u = __float_as_uint(f); return (u + 0x7fffu + ((u >> 16) & 1u)) >> 16; }
__device__ __forceinline__ unsigned pk2(float lo, float hi) { return f2bf(lo) | (f2bf(hi) << 16); }
__device__ __forceinline__ float lo16(unsigned v) { return __uint_as_float(v << 16); }
__device__ __forceinline__ float hi16(unsigned v) { return __uint_as_float(v & 0xffff0000u); }
#define UNPACK8(v, f) do { f[0] = lo16((v).x); f[1] = hi16((v).x); f[2] = lo16((v).y); f[3] = hi16((v).y); f[4] = lo16((v).z); f[5] = hi16((v).z); f[6] = lo16((v).w); f[7] = hi16((v).w); } while (0)
__device__ __forceinline__ float sigmoidf_(float x) { return 1.f / (1.f + __expf(-x)); }
__device__ __forceinline__ float siluf_(float x) { return x / (1.f + __expf(-x)); }
__device__ __forceinline__ float softplusf_(float x) { return x > 20.f ? x : log1pf(__expf(x)); }
__device__ __forceinline__ float wave_sum(float v) {
#pragma unroll
    for (int o = 1; o < 64; o <<= 1) v += __shfl_xor(v, o);
    return v;
}
__device__ __forceinline__ float wave_max(float v) {
#pragma unroll
    for (int o = 1; o < 64; o <<= 1) v = fmaxf(v, __shfl_xor(v, o));
    return v;
}
__device__ __forceinline__ void rot_cs(float pos, int i, float& c, float& s) {
    const float ci = __builtin_amdgcn_exp2f(-(float)i * 0.20762050593046014f) * 0.15915494309189535f;
    float rev = pos * ci; rev = rev - floorf(rev);
    s = __builtin_amdgcn_sinf(rev); c = __builtin_amdgcn_cosf(rev);
}

namespace pg8 {
constexpr int BM = 256, BK = 64, HALF = 128, HTB = HALF * BK * 2, STAGE_BYTES = 8 * HTB, NXCD = 8, WGM = 8;
__host__ __device__ __forceinline__ int lds_byte(int r, int c) { const int st = (r >> 4) * 2 + (c >> 5), rr = r & 15, cc = c & 31, ob = rr * 64 + cc * 2; return st * 1024 + (ob ^ (((ob >> 9) & 1) << 5)); }
__host__ __device__ __forceinline__ void stage_rc(int b, int& R, int& C) { const int st = b / 1024, sb = b % 1024, swz = sb ^ (((sb >> 9) & 1) << 5); R = (st >> 1) * 16 + swz / 64; C = (st & 1) * 32 + (swz % 64) / 2; }
__host__ __device__ __forceinline__ int perm32(int rho) { const int n = rho >> 4, i = rho & 15; return 8 * (i >> 2) + 4 * n + (i & 3); }
struct Unit { int pm, pn; };
struct Gemm { const bf16_t* A; const bf16_t* Bt; int M, N, K, lda, ldb; };
struct StaticOrder {
    int nM, nN, nwg, G, c;
    __device__ void init(int M, int N, int G_, int c_) { nM = M / BM; nN = N / BM; nwg = nM * nN; G = G_; c = c_; }
    __device__ bool next(int i, Unit& u) const {
        const long L = (long)i * G + c; if (L >= nwg) return false;
        int wgid = (int)L; { const int q = nwg / NXCD, r = nwg % NXCD, xcd = wgid % NXCD, off = wgid / NXCD; wgid = (xcd < r ? xcd * (q + 1) : r * (q + 1) + (xcd - r) * q) + off; }
        const int nig = WGM * nN, gid = wgid / nig, fm = gid * WGM, gsz = (nM - fm) < WGM ? (nM - fm) : WGM;
        u.pm = fm + ((wgid % nig) % gsz); u.pn = (wgid % nig) / gsz; return true;
    }
};
template <class Epi, bool ALIGN_EPI>
__device__ __forceinline__ void gemm_phase(LAS unsigned char* lds, const Gemm g, const StaticOrder& S, const Epi& E) {
    const int tid = otid(), wid = __builtin_amdgcn_readfirstlane(tid >> 6), lane = tid & 63, wr = wid >> 2, wc = wid & 3, fr = lane & 15, fq = lane >> 4;
    const int K = g.K, nt = K / BK;
    unsigned voffA[2], voffB[2];
#pragma unroll
    for (int i = 0; i < 2; ++i) { int R, C; stage_rc(tid * 16 + i * 8192, R, C); const int Rb = (R & ~31) + perm32(R & 31);
        voffA[i] = (unsigned)(R * g.lda + C) * 2u; voffB[i] = (unsigned)(Rb * g.ldb + C) * 2u; }
    const size_t kstep = (size_t)(BK * 2);
    const size_t hstepA = (size_t)HALF * g.lda * 2, hstepB = (size_t)HALF * g.ldb * 2;
    const size_t tstepA = 2 * hstepA, tstepB = 2 * hstepB;
    const unsigned ldsw = (unsigned)wid * 1024u;
    const int aoff = lds_byte(wr * 64 + fr, fq * 8), boff = lds_byte(wc * 32 + fr, fq * 8);
#define PG8_SA(b, h) (((b) * 2 + (h)) * HTB)
#define PG8_SB(b, h) ((4 + (b) * 2 + (h)) * HTB)
#define PG8_STAGE(bufoff, gbase, voff) do { _Pragma("unroll") for (int _i = 0; _i < 2; ++_i) \
        __builtin_amdgcn_global_load_lds((const unsigned*)((const char*)(gbase) + (voff)[_i]), (LAS unsigned*)(lds + (bufoff) + ldsw + _i * 8192), 16, 0, 0); } while (0)
#define PG8_LDA(dst, b, h) do { _Pragma("unroll") for (int m = 0; m < 4; ++m) _Pragma("unroll") for (int k = 0; k < 2; ++k) dst[m][k] = *(const LAS bf16x8*)(lds + PG8_SA(b, h) + aoff + m * 2048 + k * 1024); } while (0)
#define PG8_LDB(dst, b, h) do { _Pragma("unroll") for (int n = 0; n < 2; ++n) _Pragma("unroll") for (int k = 0; k < 2; ++k) dst[n][k] = *(const LAS bf16x8*)(lds + PG8_SB(b, h) + boff + n * 2048 + k * 1024); } while (0)
#define PG8_MMA(ai, bj, At, Bt) do { __builtin_amdgcn_s_setprio(1); _Pragma("unroll") for (int m = 0; m < 4; ++m) _Pragma("unroll") for (int n = 0; n < 2; ++n) _Pragma("unroll") for (int k = 0; k < 2; ++k) \
        acc[ai][bj][m][n] = __builtin_amdgcn_mfma_f32_16x16x32_bf16(Bt[n][k], At[m][k], acc[ai][bj][m][n], 0, 0, 0); __builtin_amdgcn_s_setprio(0); } while (0)
#define PG8_WAIT_V(n) asm volatile("s_waitcnt vmcnt(" #n ")" ::: "memory")
#define PG8_WAIT_L(n) asm volatile("s_waitcnt lgkmcnt(" #n ")" ::: "memory")
#define PG8_BAR __builtin_amdgcn_s_barrier()
#define PG8_SCHED __builtin_amdgcn_sched_barrier(0)
    Unit cur, nxt; int ui = 0;
    if (!S.next(0, cur)) return;
    f32x4 acc[2][2][4][2];
#pragma unroll
    for (int a = 0; a < 2; ++a)
#pragma unroll
        for (int b = 0; b < 2; ++b)
#pragma unroll
            for (int m = 0; m < 4; ++m)
#pragma unroll
                for (int n = 0; n < 2; ++n) acc[a][b][m][n] = (f32x4){0.f, 0.f, 0.f, 0.f};
    bf16x8 At[4][2], B0[2][2], B1[2][2];
    const char* cA = (const char*)g.A + (size_t)cur.pm * tstepA; const char* cB = (const char*)g.Bt + (size_t)cur.pn * tstepB;
    PG8_STAGE(PG8_SB(0, 0), cB, voffB); PG8_STAGE(PG8_SB(0, 1), cB + hstepB, voffB); PG8_STAGE(PG8_SA(0, 0), cA, voffA); PG8_STAGE(PG8_SA(0, 1), cA + hstepA, voffA);
    if (wr == 1) PG8_BAR;
    PG8_WAIT_V(2); PG8_BAR;
    PG8_STAGE(PG8_SB(1, 0), cB + kstep, voffB); PG8_STAGE(PG8_SA(1, 0), cA + kstep, voffA); PG8_STAGE(PG8_SB(1, 1), cB + hstepB + kstep, voffB);
    PG8_WAIT_V(6); PG8_BAR;
    for (;;) {
        const bool has_next = S.next(ui + 1, nxt);
        const char* nA = has_next ? (const char*)g.A + (size_t)nxt.pm * tstepA : cA; const char* nB = has_next ? (const char*)g.Bt + (size_t)nxt.pn * tstepB : cB;
        for (int t = 0; t < nt; t += 2) {
            const bool last = (t == nt - 2);
            const char* a1 = cA + (size_t)(t + 1) * kstep;
            const char* a2 = last ? nA : cA + (size_t)(t + 2) * kstep; const char* b2 = last ? nB : cB + (size_t)(t + 2) * kstep;
            const char* a3 = a2 + kstep; const char* b3 = b2 + kstep;
            PG8_LDB(B0, 0, 0); PG8_LDB(B1, 0, 1); PG8_SCHED; PG8_LDA(At, 0, 0); PG8_STAGE(PG8_SA(1, 1), a1 + hstepA, voffA);
            PG8_WAIT_V(8); PG8_WAIT_L(0); PG8_BAR; PG8_MMA(0, 0, At, B0); PG8_MMA(0, 1, At, B1); PG8_BAR; PG8_SCHED;
            PG8_LDA(At, 0, 1); PG8_STAGE(PG8_SB(0, 0), b2, voffB); PG8_STAGE(PG8_SB(0, 1), b2 + hstepB, voffB); PG8_STAGE(PG8_SA(0, 0), a2, voffA);
            PG8_WAIT_V(8); PG8_WAIT_L(0); PG8_BAR; PG8_MMA(1, 0, At, B0); PG8_MMA(1, 1, At, B1); PG8_BAR; PG8_SCHED;
            PG8_LDB(B0, 1, 0); PG8_LDB(B1, 1, 1); PG8_SCHED; PG8_LDA(At, 1, 0); PG8_STAGE(PG8_SA(0, 1), a2 + hstepA, voffA);
            PG8_WAIT_V(8); PG8_WAIT_L(0); PG8_BAR; PG8_MMA(0, 0, At, B0); PG8_MMA(0, 1, At, B1); PG8_BAR; PG8_SCHED;
            PG8_LDA(At, 1, 1); PG8_STAGE(PG8_SB(1, 0), b3, voffB); PG8_STAGE(PG8_SB(1, 1), b3 + hstepB, voffB); PG8_STAGE(PG8_SA(1, 0), a3, voffA);
            PG8_WAIT_V(8); PG8_WAIT_L(0); PG8_BAR; PG8_MMA(1, 0, At, B0); PG8_MMA(1, 1, At, B1); PG8_BAR; PG8_SCHED;
        }
        if constexpr (ALIGN_EPI) { if (wr == 0) PG8_BAR; }
        E(acc, cur, wr, wc, fr, fq);
        if (!has_next) break;
#pragma unroll
        for (int a = 0; a < 2; ++a)
#pragma unroll
            for (int b = 0; b < 2; ++b)
#pragma unroll
                for (int m = 0; m < 4; ++m)
#pragma unroll
                    for (int n = 0; n < 2; ++n) acc[a][b][m][n] = (f32x4){0.f, 0.f, 0.f, 0.f};
        cur = nxt; cA = nA; cB = nB; ++ui;
        if constexpr (ALIGN_EPI) { if (wr == 1) PG8_BAR; }
    }
    PG8_WAIT_V(0);
    if constexpr (!ALIGN_EPI) { if (wr == 0) PG8_BAR; }
    PG8_BAR;
#undef PG8_SA
#undef PG8_SB
#undef PG8_STAGE
#undef PG8_LDA
#undef PG8_LDB
#undef PG8_MMA
#undef PG8_WAIT_V
#undef PG8_WAIT_L
#undef PG8_BAR
#undef PG8_SCHED
}
}

struct EpiBf16 {
    bf16_t* O; int ldc;
    __device__ __forceinline__ void operator()(const f32x4 (&acc)[2][2][4][2], const pg8::Unit& u, int wr, int wc, int fr, int fq) const {
        const int row0 = u.pm * 256 + wr * 64 + fr, col0 = u.pn * 256 + wc * 32 + 8 * fq;
#pragma unroll
        for (int ai = 0; ai < 2; ++ai)
#pragma unroll
            for (int m = 0; m < 4; ++m) { bf16_t* rowp = O + (size_t)(row0 + ai * 128 + m * 16) * ldc + col0;
#pragma unroll
                for (int bj = 0; bj < 2; ++bj) { const f32x4 v0 = acc[ai][bj][m][0], v1 = acc[ai][bj][m][1];
                    u32x4 w; w.x = pk2(v0[0], v0[1]); w.y = pk2(v0[2], v0[3]); w.z = pk2(v1[0], v1[1]); w.w = pk2(v1[2], v1[3]);
                    *(u32x4*)(rowp + bj * 128) = w; } }
    }
};
struct EpiGU {
    bf16_t* H;
    __device__ __forceinline__ void operator()(const f32x4 (&acc)[2][2][4][2], const pg8::Unit& u, int wr, int wc, int fr, int fq) const {
        const int row0 = u.pm * 256 + wr * 64 + fr, col0 = u.pn * 256 + wc * 32 + 8 * fq;
#pragma unroll
        for (int ai = 0; ai < 2; ++ai)
#pragma unroll
            for (int m = 0; m < 4; ++m) { bf16_t* rowp = H + (size_t)(row0 + ai * 128 + m * 16) * DFF + (col0 >> 1);
#pragma unroll
                for (int bj = 0; bj < 2; ++bj) { const f32x4 v0 = acc[ai][bj][m][0], v1 = acc[ai][bj][m][1];
                    u32x2 w; w.x = pk2(siluf_(v0[0]) * v1[0], siluf_(v0[1]) * v1[1]); w.y = pk2(siluf_(v0[2]) * v1[2], siluf_(v0[3]) * v1[3]);
                    *(u32x2*)(rowp + bj * 64) = w; } }
    }
};
struct EpiRes {
    const float* X; float* V;
    __device__ __forceinline__ void operator()(const f32x4 (&acc)[2][2][4][2], const pg8::Unit& u, int wr, int wc, int fr, int fq) const {
        const int row0 = u.pm * 256 + wr * 64 + fr, col0 = u.pn * 256 + wc * 32 + 8 * fq;
#pragma unroll
        for (int ai = 0; ai < 2; ++ai)
#pragma unroll
            for (int m = 0; m < 4; ++m) { const size_t off = (size_t)(row0 + ai * 128 + m * 16) * DM + col0;
#pragma unroll
                for (int bj = 0; bj < 2; ++bj) {
                    const f32x4 x0 = *(const f32x4*)(X + off + bj * 128), x1 = *(const f32x4*)(X + off + bj * 128 + 4);
                    *(f32x4*)(V + off + bj * 128) = x0 * ALPHA + acc[ai][bj][m][0]; *(f32x4*)(V + off + bj * 128 + 4) = x1 * ALPHA + acc[ai][bj][m][1]; } }
    }
};
struct EpiBranch {
    const bf16_t* U; const float* RSTD; float* MIX; bf16_t* MIXB; int br;
    __device__ __forceinline__ void operator()(const f32x4 (&acc)[2][2][4][2], const pg8::Unit& u, int wr, int wc, int fr, int fq) const {
        const int row0 = u.pm * 256 + wr * 64 + fr, col0 = u.pn * 256 + wc * 32 + 8 * fq;
        const int gcol = U_GATE + (br == 0 ? 0 : (br == 3 ? 2048 : 1024));
#pragma unroll
        for (int ai = 0; ai < 2; ++ai)
#pragma unroll
            for (int m = 0; m < 4; ++m) { const int row = row0 + ai * 128 + m * 16; const size_t off = (size_t)row * DM + col0;
                float rs = 1.f; if (br == 1) rs = RSTD[row * 2]; else if (br == 2) rs = RSTD[row * 2 + 1];
#pragma unroll
                for (int bj = 0; bj < 2; ++bj) {
                    const u32x4 gv = *(const u32x4*)(U + (size_t)row * NU + gcol + col0 + bj * 128); float gf[8]; UNPACK8(gv, gf);
                    f32x4 v0 = acc[ai][bj][m][0], v1 = acc[ai][bj][m][1];
#pragma unroll
                    for (int e = 0; e < 4; ++e) { v0[e] *= rs * sigmoidf_(gf[e]); v1[e] *= rs * sigmoidf_(gf[4 + e]); }
                    float* mp = MIX + off + bj * 128;
                    if (br != 0) { v0 += *(const f32x4*)mp; v1 += *(const f32x4*)(mp + 4); }
                    if (br != 3) { *(f32x4*)mp = v0; *(f32x4*)(mp + 4) = v1; }
                    else { u32x4 w; w.x = pk2(v0[0], v0[1]); w.y = pk2(v0[2], v0[3]); w.z = pk2(v1[0], v1[1]); w.w = pk2(v1[2], v1[3]); *(u32x4*)(MIXB + off + bj * 128) = w; } } }
    }
};

struct Args { const float* in[27]; float* out; unsigned char* ws; int ph_lo, ph_hi; };
struct Ctx {
    const float* const* in; float* out; unsigned char* ws;
    bf16_t *XB, *U, *ABR, *MIXB, *H, *XBCC; float *XF, *MIX, *KV, *ST, *CSL, *RSTD;
    int l;
};

template <int NB, int KS>
__device__ __forceinline__ void mm_strip(f32x4 (&acc)[NB], const LAS unsigned char* A, int lda_b, const LAS unsigned char* Bt, int ldb_b, int fr, int fq) {
#pragma unroll
    for (int ks = 0; ks < KS; ++ks) {
        const bf16x8 a = *(const LAS bf16x8*)(A + fr * lda_b + ks * 64 + fq * 16);
#pragma unroll
        for (int nb = 0; nb < NB; ++nb) {
            const bf16x8 b = *(const LAS bf16x8*)(Bt + (nb * 16 + fr) * ldb_b + ks * 64 + fq * 16);
            acc[nb] = __builtin_amdgcn_mfma_f32_16x16x32_bf16(b, a, acc[nb], 0, 0, 0);
        }
    }
}

__device__ __forceinline__ int dest_row(int mode, int n) {
    if (mode == 1) return n < 4608 ? n : (n < 4624 ? 8448 + (n - 4608) : n - 16);
    if (mode == 2) return 8 * (n >> 2) + (n & 3);
    if (mode == 3) return 8 * (n >> 2) + 4 + (n & 3);
    return n;
}
__device__ __forceinline__ void transpose_item(const float* W, int K, int N, bf16_t* WT, int ldk, int koff, int mode, const float* kscale, LAS float* scr, int item, int lane) {
    const int nblk = (N + 31) / 32, kb = item / nblk, nb = item % nblk, k0 = 64 * kb, n0 = 32 * nb;
    const int nn = n0 + (lane & 31);
#pragma unroll 8
    for (int i = 0; i < 32; ++i) { const int kk = 2 * i + (lane >> 5); float v = 0.f; if (nn < N) { v = W[(size_t)(k0 + kk) * N + nn]; if (kscale) v *= kscale[k0 + kk]; } scr[kk * 33 + (lane & 31)] = v; }
    asm volatile("s_waitcnt lgkmcnt(0)" ::: "memory");
    const int c = lane & 7;
#pragma unroll
    for (int j = 0; j < 4; ++j) { const int n = (lane >> 3) + 8 * j; const LAS float* s = scr + (8 * c) * 33 + n;
        u32x4 o; o.x = pk2(s[0 * 33], s[1 * 33]); o.y = pk2(s[2 * 33], s[3 * 33]); o.z = pk2(s[4 * 33], s[5 * 33]); o.w = pk2(s[6 * 33], s[7 * 33]);
        if (n0 + n < N) *(u32x4*)(WT + (size_t)dest_row(mode, n0 + n) * ldk + koff + k0 + 8 * c) = o; }
    asm volatile("s_waitcnt lgkmcnt(0)" ::: "memory");
}
__device__ __forceinline__ bf16_t* wl(unsigned char* ws, int l, size_t off) { return (bf16_t*)(ws + WS_W + (size_t)l * SZ_WL + off); }
constexpr size_t OFF_WIN = 0, OFF_WBR = SZ_WIN, OFF_WOUT = OFF_WBR + SZ_WBR, OFF_WGU = OFF_WOUT + SZ_WOUT, OFF_WDN = OFF_WGU + SZ_WGU;

__device__ __forceinline__ void prologue(const Ctx& c, LAS unsigned char* lds) {
    const int tid = otid(), wave = tid >> 6, lane = tid & 63;
    const int G = gridDim.x, gw = blockIdx.x * 8 + wave, NGW = G * 8;
    LAS float* scr = (LAS float*)(lds + wave * 16384);
    constexpr int I_IN = 16 * 265, I_R = 8 * 32, I_S = 16 * 32, I_O = 16 * 32, I_G = 16 * 88, I_D = 44 * 32;
    constexpr int I_LAYER = I_IN + I_R + I_S + I_R + I_O + I_G + I_G + I_D;
    for (int it = gw; it < NLAYER * I_LAYER; it += NGW) {
        const int l = it / I_LAYER; int r = it % I_LAYER;
        if (r < I_IN) { transpose_item(c.in[7] + (size_t)l * DM * NIN, DM, NIN, wl(c.ws, l, OFF_WIN), DM, 0, 1, nullptr, scr, r, lane); continue; } r -= I_IN;
        if (r < I_R) { transpose_item(c.in[16] + (size_t)l * 512 * DM, 512, DM, wl(c.ws, l, OFF_WBR), KBR, 0, 0, nullptr, scr, r, lane); continue; } r -= I_R;
        if (r < I_S) { transpose_item(c.in[17] + (size_t)l * 1024 * DM, 1024, DM, wl(c.ws, l, OFF_WBR), KBR, 512, 0, c.in[13] + l * 1024, scr, r, lane); continue; } r -= I_S;
        if (r < I_R) { transpose_item(c.in[18] + (size_t)l * 512 * DM, 512, DM, wl(c.ws, l, OFF_WBR), KBR, 1536, 0, nullptr, scr, r, lane); continue; } r -= I_R;
        if (r < I_O) { transpose_item(c.in[19] + (size_t)l * DM * DM, DM, DM, wl(c.ws, l, OFF_WOUT), DM, 0, 0, nullptr, scr, r, lane); continue; } r -= I_O;
        if (r < I_G) { transpose_item(c.in[24] + (size_t)l * DM * DFF, DM, DFF, wl(c.ws, l, OFF_WGU), DM, 0, 2, nullptr, scr, r, lane); continue; } r -= I_G;
        if (r < I_G) { transpose_item(c.in[25] + (size_t)l * DM * DFF, DM, DFF, wl(c.ws, l, OFF_WGU), DM, 0, 3, nullptr, scr, r, lane); continue; } r -= I_G;
        transpose_item(c.in[26] + (size_t)l * DFF * DM, DFF, DM, wl(c.ws, l, OFF_WDN), DFF, 0, 0, nullptr, scr, r, lane);
    }
    const int gt = blockIdx.x * 512 + tid, NT = G * 512;
    for (int i = gt; i < NLAYER * 240 * 128; i += NT) { const int l = i / (240 * 128), r = i % (240 * 128); *(u32x4*)(wl(c.ws, l, OFF_WIN) + (size_t)(NIN + r / 128) * DM + (r % 128) * 8) = (u32x4){0u, 0u, 0u, 0u}; }
    for (int i = gt; i < MP * (DM / 4); i += NT) { const int row = i >> 8, c4 = (i & 255) * 4;
        f32x4 v = (f32x4){0.f, 0.f, 0.f, 0.f};
        if (row < MPR) v = *(const f32x4*)(c.in[0] + (size_t)row * DM + c4); else if (row < MREAL) v = *(const f32x4*)(c.in[1] + (size_t)(row - MPR) * DM + c4);
        *(f32x4*)(c.XF + (size_t)row * DM + c4) = v; u32x2 w; w.x = pk2(v[0], v[1]); w.y = pk2(v[2], v[3]); *(u32x2*)(c.XB + (size_t)row * DM + c4) = w; }
}

__device__ __forceinline__ void ln_phase(const Ctx& c, const float* g, const float* b, bool final_out) {
    const int tid = otid(), wave = tid >> 6, lane = tid & 63;
    const int gw = blockIdx.x * 8 + wave, NGW = gridDim.x * 8;
    for (int row = gw; row < MREAL; row += NGW) {
        const f32x4* xr = (const f32x4*)(c.MIX + (size_t)row * DM) + lane;
        f32x4 v[4]; float s = 0.f;
#pragma unroll
        for (int j = 0; j < 4; ++j) { v[j] = xr[64 * j]; s += (v[j][0] + v[j][1]) + (v[j][2] + v[j][3]); }
        const float mean = wave_sum(s) * (1.f / DM); float s2 = 0.f;
#pragma unroll
        for (int j = 0; j < 4; ++j) { v[j] = v[j] - mean; s2 += (v[j][0] * v[j][0] + v[j][1] * v[j][1]) + (v[j][2] * v[j][2] + v[j][3] * v[j][3]); }
        const float rstd = rsqrtf(wave_sum(s2) * (1.f / DM) + EPS);
#pragma unroll
        for (int j = 0; j < 4; ++j) { const int col = (lane + 64 * j) * 4; const f32x4 gg = *(const f32x4*)(g + col), bb = *(const f32x4*)(b + col);
            const f32x4 o = v[j] * rstd * gg + bb;
            if (final_out) *(f32x4*)(c.out + O_Y + (size_t)row * DM + col) = o;
            else { *(f32x4*)(c.XF + (size_t)row * DM + col) = o; u32x2 w; w.x = pk2(o[0], o[1]); w.y = pk2(o[2], o[3]); *(u32x2*)(c.XB + (size_t)row * DM + col) = w; } }
    }
}

__device__ __forceinline__ void conv8(const Ctx& c, int row, int t, int cb, float (&o)[8]) {
    const float* cw = c.in[8] + (size_t)c.l * 4 * 1536 + cb; const float* cbias = c.in[9] + (size_t)c.l * 1536 + cb;
    { const f32x4 b0 = *(const f32x4*)cbias, b1 = *(const f32x4*)(cbias + 4); o[0] = b0[0]; o[1] = b0[1]; o[2] = b0[2]; o[3] = b0[3]; o[4] = b1[0]; o[5] = b1[1]; o[6] = b1[2]; o[7] = b1[3]; }
#pragma unroll
    for (int tau = 0; tau < 4; ++tau) {
        const int dt = tau - 3;
        if (t + dt >= 0) {
            const u32x4 xv = *(const u32x4*)(c.U + (size_t)(row + dt) * NU + U_XBC + cb); float xf[8]; UNPACK8(xv, xf);
            const f32x4 w0 = *(const f32x4*)(cw + tau * 1536), w1 = *(const f32x4*)(cw + tau * 1536 + 4);
            o[0] += w0[0] * xf[0]; o[1] += w0[1] * xf[1]; o[2] += w0[2] * xf[2]; o[3] += w0[3] * xf[3]; o[4] += w1[0] * xf[4]; o[5] += w1[1] * xf[5]; o[6] += w1[2] * xf[6]; o[7] += w1[3] * xf[7];
        }
    }
#pragma unroll
    for (int e = 0; e < 8; ++e) o[e] = siluf_(o[e]);
}
__device__ __forceinline__ void ssd_dtcs(const Ctx& c, int row0, int g, LAS float* dtS, LAS float* csS, int w, int lane, float* csl_out) {
    const int h = g * 8 + w;
    const float bias = c.in[10][c.l * 16 + h], a = -__expf(c.in[11][c.l * 16 + h]);
    const int j = 2 * lane;
    const float d0 = softplusf_(bf2f(c.U[(size_t)(row0 + j) * NU + U_DT + h]) + bias), d1 = softplusf_(bf2f(c.U[(size_t)(row0 + j + 1) * NU + U_DT + h]) + bias);
    const float v0 = d0 * a, v1 = d1 * a; float s = v0 + v1;
#pragma unroll
    for (int o = 1; o < 64; o <<= 1) { const float t = __shfl_up(s, o); if (lane >= o) s += t; }
    const float ex = s - (v0 + v1);
    dtS[w * 128 + j] = d0; dtS[w * 128 + j + 1] = d1; csS[w * 128 + j] = ex + v0; csS[w * 128 + j + 1] = s;
    if (csl_out && lane == 63) *csl_out = s;
}

constexpr int LD136 = 272;
typedef short s16x4 __attribute__((ext_vector_type(4)));
__device__ __forceinline__ bf16x8 tr_frag(const LAS bf16_t* T, int ld, int col0, int krow0, int lane) {
    const int g = lane >> 4, q = (lane & 15) >> 2, p = lane & 3;
    LAS s16x4* a0 = (LAS s16x4*)(T + (krow0 + 8 * g + q) * ld + col0 + 4 * p);
    const s16x4 lo = __builtin_amdgcn_ds_read_tr16_b64_v4i16(a0);
    const s16x4 hi = __builtin_amdgcn_ds_read_tr16_b64_v4i16(a0 + ld);
    return __builtin_shufflevector(lo, hi, 0, 1, 2, 3, 4, 5, 6, 7);
}
#define ZERO_ACC(a, n) _Pragma("unroll") for (int _z = 0; _z < (n); ++_z) a[_z] = (f32x4){0.f, 0.f, 0.f, 0.f}
#define PACK8(o, f) do { (o).x = pk2(f[0], f[1]); (o).y = pk2(f[2], f[3]); (o).z = pk2(f[4], f[5]); (o).w = pk2(f[6], f[7]); } while (0)

__device__ __forceinline__ void ret1_tile(const Ctx& c, int item, LAS unsigned char* lds) {
    const int tid = otid(), w = tid >> 6, lane = tid & 63, fr = lane & 15, fq = lane >> 4;
    const int n = item & 15, h = (item >> 4) & 3, b = item >> 6;
    const int row0 = b * PL + n * 128;
    const float lg = __logf(1.f - exp2f(-5.f - (float)h));
    LAS bf16_t* Ks = (LAS bf16_t*)lds; LAS bf16_t* Vs = Ks + 128 * 136;
#pragma unroll
    for (int r = 0; r < 2; ++r) { const int unit = tid + 512 * r, dg = unit & 7, j = unit >> 3;
        const bf16_t* src = c.U + (size_t)(row0 + j) * NU + U_KR + h * 128 + dg * 8;
        const u32x4 lo = *(const u32x4*)src, hi = *(const u32x4*)(src + 64); float fl[8], fh[8]; UNPACK8(lo, fl); UNPACK8(hi, fh);
        const float pos = (float)(n * 128 + j), sc = 0.08838834764831845f * __expf(lg * (float)(127 - j)); float k1[8], k2[8];
#pragma unroll
        for (int e = 0; e < 8; ++e) { float cs, sn; rot_cs(pos, dg * 8 + e, cs, sn); k1[e] = (fl[e] * cs - fh[e] * sn) * sc; k2[e] = (fl[e] * sn + fh[e] * cs) * sc; }
        u32x4 o; PACK8(o, k1); *(LAS u32x4*)(Ks + j * 136 + dg * 8) = o; PACK8(o, k2); *(LAS u32x4*)(Ks + j * 136 + 64 + dg * 8) = o; }
#pragma unroll
    for (int r = 0; r < 4; ++r) { const int unit = tid + 512 * r, vg = unit & 15, j = unit >> 4;
        *(LAS u32x4*)(Vs + j * 136 + vg * 8) = *(const u32x4*)(c.U + (size_t)(row0 + j) * NU + U_VR + h * 128 + vg * 8); }
    __syncthreads();
    f32x4 acc[8]; ZERO_ACC(acc, 8);
#pragma unroll
    for (int ks = 0; ks < 4; ++ks) { const bf16x8 a = tr_frag(Ks, 136, 16 * w, 32 * ks, lane);
#pragma unroll
        for (int nb = 0; nb < 8; ++nb) { const bf16x8 bb = tr_frag(Vs, 136, 16 * nb, 32 * ks, lane); acc[nb] = __builtin_amdgcn_mfma_f32_16x16x32_bf16(bb, a, acc[nb], 0, 0, 0); } }
    float* dst = c.KV + ((size_t)((b * 4 + h) * 16 + n)) * 16384 + (16 * w + fr) * 128 + 4 * fq;
#pragma unroll
    for (int nb = 0; nb < 8; ++nb) *(f32x4*)(dst + 16 * nb) = acc[nb];
    __syncthreads();
}

__device__ __forceinline__ void ret2_tile(const Ctx& c, int item, LAS unsigned char* lds) {
    const int tid = otid(), w = tid >> 6, lane = tid & 63, fr = lane & 15, fq = lane >> 4;
    const int n = item & 15, h = (item >> 4) & 3, b = item >> 6;
    const int row0 = b * PL + n * 128;
    const float lg = __logf(1.f - exp2f(-5.f - (float)h));
    LAS bf16_t* Qs = (LAS bf16_t*)lds; LAS bf16_t* Ks = Qs + 128 * 136; LAS bf16_t* Vs = Ks + 128 * 136; LAS bf16_t* Ss = Vs + 128 * 136;
#pragma unroll
    for (int r = 0; r < 2; ++r) { const int unit = tid + 512 * r, dg = unit & 7, j = unit >> 3;
        const bf16_t* qsrc = c.U + (size_t)(row0 + j) * NU + U_QR + h * 128 + dg * 8; const bf16_t* ksrc = qsrc + (U_KR - U_QR);
        const u32x4 qlo = *(const u32x4*)qsrc, qhi = *(const u32x4*)(qsrc + 64), klo = *(const u32x4*)ksrc, khi = *(const u32x4*)(ksrc + 64);
        float ql[8], qh[8], kl[8], kh[8]; UNPACK8(qlo, ql); UNPACK8(qhi, qh); UNPACK8(klo, kl); UNPACK8(khi, kh);
        const float pos = (float)(n * 128 + j); float q1[8], q2[8], k1[8], k2[8];
#pragma unroll
        for (int e = 0; e < 8; ++e) { float cs, sn; rot_cs(pos, dg * 8 + e, cs, sn);
            q1[e] = ql[e] * cs - qh[e] * sn; q2[e] = ql[e] * sn + qh[e] * cs;
            k1[e] = (kl[e] * cs - kh[e] * sn) * 0.08838834764831845f; k2[e] = (kl[e] * sn + kh[e] * cs) * 0.08838834764831845f; }
        u32x4 o;
        PACK8(o, q1); *(LAS u32x4*)(Qs + j * 136 + dg * 8) = o; PACK8(o, q2); *(LAS u32x4*)(Qs + j * 136 + 64 + dg * 8) = o;
        PACK8(o, k1); *(LAS u32x4*)(Ks + j * 136 + dg * 8) = o; PACK8(o, k2); *(LAS u32x4*)(Ks + j * 136 + 64 + dg * 8) = o; }
    { const float* sb = c.KV + ((size_t)((b * 4 + h) * 16 + n)) * 16384;
#pragma unroll
      for (int r = 0; r < 4; ++r) { const int unit = tid + 512 * r, vg = unit & 15, j = unit >> 4;
          *(LAS u32x4*)(Vs + j * 136 + vg * 8) = *(const u32x4*)(c.U + (size_t)(row0 + j) * NU + U_VR + h * 128 + vg * 8);
          const f32x4 s0 = *(const f32x4*)(sb + j * 128 + vg * 8), s1 = *(const f32x4*)(sb + j * 128 + vg * 8 + 4);
          u32x4 o; o.x = pk2(s0[0], s0[1]); o.y = pk2(s0[2], s0[3]); o.z = pk2(s1[0], s1[1]); o.w = pk2(s1[2], s1[3]); *(LAS u32x4*)(Ss + j * 136 + vg * 8) = o; } }
    __syncthreads();
    f32x4 acc[8]; ZERO_ACC(acc, 8);
    mm_strip<8, 4>(acc, (const LAS unsigned char*)Qs + w * 16 * LD136, LD136, (const LAS unsigned char*)Ks, LD136, fr, fq);
    const int i = 16 * w + fr;
    __syncthreads();
#pragma unroll
    for (int nb = 0; nb < 8; ++nb) { float p[4];
#pragma unroll
        for (int e = 0; e < 4; ++e) { const int dl = i - (16 * nb + 4 * fq + e); p[e] = dl >= 0 ? acc[nb][e] * __expf(lg * (float)dl) : 0.f; }
        u32x2 o; o.x = pk2(p[0], p[1]); o.y = pk2(p[2], p[3]); *(LAS u32x2*)(Ks + i * 136 + 16 * nb + 4 * fq) = o; }
    f32x4 a2[8], a3[8]; ZERO_ACC(a2, 8); ZERO_ACC(a3, 8);
#pragma unroll
    for (int ks = 0; ks < 4; ++ks) {
        const bf16x8 ap = *(const LAS bf16x8*)(Ks + i * 136 + ks * 32 + fq * 8), aq = *(const LAS bf16x8*)(Qs + i * 136 + ks * 32 + fq * 8);
#pragma unroll
        for (int nb = 0; nb < 8; ++nb) { const bf16x8 bv = tr_frag(Vs, 136, 16 * nb, 32 * ks, lane), bs = tr_frag(Ss, 136, 16 * nb, 32 * ks, lane);
            a2[nb] = __builtin_amdgcn_mfma_f32_16x16x32_bf16(bv, ap, a2[nb], 0, 0, 0); a3[nb] = __builtin_amdgcn_mfma_f32_16x16x32_bf16(bs, aq, a3[nb], 0, 0, 0); } }
    const float qd = __expf(lg * (float)(i + 1)); float s = 0.f;
#pragma unroll
    for (int nb = 0; nb < 8; ++nb) { a2[nb] = a2[nb] + a3[nb] * qd; s += (a2[nb][0] + a2[nb][1]) + (a2[nb][2] + a2[nb][3]); }
    s += __shfl_xor(s, 16); s += __shfl_xor(s, 32);
    const float mean = s * (1.f / 128.f); float q = 0.f;
#pragma unroll
    for (int nb = 0; nb < 8; ++nb) { a2[nb] = a2[nb] - mean; q += (a2[nb][0] * a2[nb][0] + a2[nb][1] * a2[nb][1]) + (a2[nb][2] * a2[nb][2] + a2[nb][3] * a2[nb][3]); }
    q += __shfl_xor(q, 16); q += __shfl_xor(q, 32);
    const float rstd = rsqrtf(q * (1.f / 128.f) + EPS);
    const bf16_t* gp = c.U + (size_t)(row0 + i) * NU + U_GR + h * 128 + 4 * fq; bf16_t* op = c.ABR + (size_t)(row0 + i) * KBR + h * 128 + 4 * fq;
#pragma unroll
    for (int nb = 0; nb < 8; ++nb) { const u32x2 gv = *(const u32x2*)(gp + 16 * nb);
        const float g0 = siluf_(lo16(gv.x)), g1 = siluf_(hi16(gv.x)), g2 = siluf_(lo16(gv.y)), g3 = siluf_(hi16(gv.y));
        u32x2 o; o.x = pk2(a2[nb][0] * rstd * g0, a2[nb][1] * rstd * g1); o.y = pk2(a2[nb][2] * rstd * g2, a2[nb][3] * rstd * g3); *(u32x2*)(op + 16 * nb) = o; }
    __syncthreads();
}

__device__ __forceinline__ void ssd1_tile(const Ctx& c, int item, LAS unsigned char* lds) {
    const int tid = otid(), w = tid >> 6, lane = tid & 63, fr = lane & 15, fq = lane >> 4;
    const int g = item & 1, n = (item >> 1) & 15, b = item >> 5;
    const int row0 = b * PL + n * 128;
    LAS bf16_t* Bs = (LAS bf16_t*)lds; LAS bf16_t* Xs = Bs + 128 * 136; LAS float* dtS = (LAS float*)(Xs + 128 * 72); LAS float* csS = dtS + 1024;
    ssd_dtcs(c, row0, g, dtS, csS, w, lane, c.CSL + (b * 16 + n) * 16 + g * 8 + w);
#pragma unroll 2
    for (int r = 0; r < 24; ++r) { const int unit = tid + 512 * r, cg = unit % 96, j = unit / 96; float o[8];
        const int cl = cg * 8, cb = cl < 512 ? g * 512 + cl : (cl < 640 ? 1024 + g * 128 + (cl - 512) : 1280 + g * 128 + (cl - 640));
        conv8(c, row0 + j, n * 128 + j, cb, o);
        u32x4 pk; PACK8(pk, o); *(u32x4*)(c.XBCC + (size_t)(row0 + j) * 1536 + cb) = pk;
        if (cl >= 512 && cl < 640) *(LAS u32x4*)(Bs + j * 136 + (cl - 512)) = pk; }
    __syncthreads();
    for (int hl = 0; hl < 8; ++hl) { const int h = g * 8 + hl;
        const float csl = csS[hl * 128 + 127];
#pragma unroll
        for (int r = 0; r < 2; ++r) { const int unit = tid + 512 * r, pg = unit & 7, j = unit >> 3; float o[8];
            const u32x4 xv = *(const u32x4*)(c.XBCC + (size_t)(row0 + j) * 1536 + h * 64 + pg * 8); UNPACK8(xv, o);
            const float sc = dtS[hl * 128 + j] * __expf(csl - csS[hl * 128 + j]);
#pragma unroll
            for (int e = 0; e < 8; ++e) o[e] *= sc;
            u32x4 pk; PACK8(pk, o); *(LAS u32x4*)(Xs + j * 72 + pg * 8) = pk; }
        __syncthreads();
        const int strip = w & 3, nh = w >> 2;
        f32x4 acc[4]; ZERO_ACC(acc, 4);
#pragma unroll
        for (int ks = 0; ks < 4; ++ks) { const bf16x8 a = tr_frag(Xs, 72, 16 * strip, 32 * ks, lane);
#pragma unroll
            for (int nb = 0; nb < 4; ++nb) { const bf16x8 bb = tr_frag(Bs, 136, nh * 64 + 16 * nb, 32 * ks, lane); acc[nb] = __builtin_amdgcn_mfma_f32_16x16x32_bf16(bb, a, acc[nb], 0, 0, 0); } }
        float* dst = c.ST + ((size_t)(((b * 16 + n) * 16 + h) * 64 + 16 * strip + fr)) * 128 + nh * 64 + 4 * fq;
#pragma unroll
        for (int nb = 0; nb < 4; ++nb) *(f32x4*)(dst + 16 * nb) = acc[nb];
        __syncthreads();
    }
}

__device__ __forceinline__ void ssd2_tile(const Ctx& c, int item, LAS unsigned char* lds) {
    const int tid = otid(), w = tid >> 6, lane = tid & 63, fr = lane & 15, fq = lane >> 4;
    const int g = item & 1, n = (item >> 1) & 15, b = item >> 5;
    const int row0 = b * PL + n * 128;
    LAS bf16_t* Cs = (LAS bf16_t*)lds; LAS bf16_t* Bs = Cs + 128 * 136; LAS bf16_t* Xs = Bs + 128 * 136; LAS bf16_t* Ss = Xs + 128 * 72;
    LAS float* dtS = (LAS float*)(Ss + 64 * 136); LAS float* csS = dtS + 1024;
    ssd_dtcs(c, row0, g, dtS, csS, w, lane, nullptr);
#pragma unroll
    for (int r = 0; r < 4; ++r) { const int unit = tid + 512 * r, sg = unit & 15, j = unit >> 4; const bf16_t* src = c.XBCC + (size_t)(row0 + j) * 1536 + 1024 + g * 128 + sg * 8;
        *(LAS u32x4*)(Bs + j * 136 + sg * 8) = *(const u32x4*)src; *(LAS u32x4*)(Cs + j * 136 + sg * 8) = *(const u32x4*)(src + 256); }
    __syncthreads();
    f32x4 cb[8]; ZERO_ACC(cb, 8);
    mm_strip<8, 4>(cb, (const LAS unsigned char*)Cs + w * 16 * LD136, LD136, (const LAS unsigned char*)Bs, LD136, fr, fq);
    __syncthreads();
    const int i = 16 * w + fr; float sumsq = 0.f;
    for (int hl = 0; hl < 8; ++hl) { const int h = g * 8 + hl;
#pragma unroll
        for (int r = 0; r < 2; ++r) { const int unit = tid + 512 * r, pg = unit & 7, j = unit >> 3;
            *(LAS u32x4*)(Xs + j * 72 + pg * 8) = *(const u32x4*)(c.XBCC + (size_t)(row0 + j) * 1536 + h * 64 + pg * 8); }
        { const float* sb = c.ST + ((size_t)(((b * 16 + n) * 16 + h) * 64)) * 128;
#pragma unroll
          for (int r = 0; r < 2; ++r) { const int unit = tid + 512 * r, s8 = unit & 15, p = unit >> 4;
              const f32x4 v0 = *(const f32x4*)(sb + p * 128 + s8 * 8), v1 = *(const f32x4*)(sb + p * 128 + s8 * 8 + 4);
              u32x4 pk; pk.x = pk2(v0[0], v0[1]); pk.y = pk2(v0[2], v0[3]); pk.z = pk2(v1[0], v1[1]); pk.w = pk2(v1[2], v1[3]); *(LAS u32x4*)(Ss + p * 136 + s8 * 8) = pk; } }
        const float csi = csS[hl * 128 + i];
#pragma unroll
        for (int nb = 0; nb < 8; ++nb) { const f32x4 csj = *(const LAS f32x4*)(csS + hl * 128 + 16 * nb + 4 * fq), dtj = *(const LAS f32x4*)(dtS + hl * 128 + 16 * nb + 4 * fq); float p[4];
#pragma unroll
            for (int e = 0; e < 4; ++e) { const int j = 16 * nb + 4 * fq + e; p[e] = (i >= j) ? cb[nb][e] * __expf(csi - csj[e]) * dtj[e] : 0.f; }
            u32x2 o; o.x = pk2(p[0], p[1]); o.y = pk2(p[2], p[3]); *(LAS u32x2*)(Bs + i * 136 + 16 * nb + 4 * fq) = o; }
        __syncthreads();
        f32x4 yi[4], yc[4]; ZERO_ACC(yi, 4); ZERO_ACC(yc, 4);
#pragma unroll
        for (int ks = 0; ks < 4; ++ks) { const bf16x8 aw = *(const LAS bf16x8*)(Bs + i * 136 + ks * 32 + fq * 8), ac = *(const LAS bf16x8*)(Cs + i * 136 + ks * 32 + fq * 8);
#pragma unroll
            for (int nb = 0; nb < 4; ++nb) { const bf16x8 bx = tr_frag(Xs, 72, 16 * nb, 32 * ks, lane), bs = *(const LAS bf16x8*)(Ss + (16 * nb + fr) * 136 + ks * 32 + fq * 8);
                yi[nb] = __builtin_amdgcn_mfma_f32_16x16x32_bf16(bx, aw, yi[nb], 0, 0, 0); yc[nb] = __builtin_amdgcn_mfma_f32_16x16x32_bf16(bs, ac, yc[nb], 0, 0, 0); } }
        const float ecs = __expf(csi), dsk = c.in[12][c.l * 16 + h];
        const bf16_t* zp = c.U + (size_t)(row0 + i) * NU + U_Z + h * 64 + 4 * fq; bf16_t* op = c.ABR + (size_t)(row0 + i) * KBR + 512 + h * 64 + 4 * fq;
#pragma unroll
        for (int nb = 0; nb < 4; ++nb) { const u32x2 zv = *(const u32x2*)(zp + 16 * nb), xv = *(const LAS u32x2*)(Xs + i * 72 + 16 * nb + 4 * fq);
            const float zz[4] = {lo16(zv.x), hi16(zv.x), lo16(zv.y), hi16(zv.y)}, xx[4] = {lo16(xv.x), hi16(xv.x), lo16(xv.y), hi16(xv.y)}; float y[4];
#pragma unroll
            for (int e = 0; e < 4; ++e) { y[e] = (yi[nb][e] + ecs * yc[nb][e] + dsk * xx[e]) * siluf_(zz[e]); sumsq += y[e] * y[e]; }
            u32x2 o; o.x = pk2(y[0], y[1]); o.y = pk2(y[2], y[3]); *(u32x2*)(op + 16 * nb) = o; }
        __syncthreads();
    }
    sumsq += __shfl_xor(sumsq, 16); sumsq += __shfl_xor(sumsq, 32);
    if (fq == 0) c.RSTD[(row0 + i) * 2 + g] = rsqrtf(sumsq * (1.f / 512.f) + EPS);
}

__device__ __forceinline__ void swa_tile(const Ctx& c, int item, LAS unsigned char* lds) {
    const int tid = otid(), w = tid >> 6, lane = tid & 63, fr = lane & 15, fq = lane >> 4;
    const int kvh = item & 1, qb = (item >> 1) & 15, b = item >> 5;
    const int row0 = b * PL + qb * 128;
    LAS bf16_t* Ks = (LAS bf16_t*)lds; LAS bf16_t* Vs = Ks + 256 * 72; LAS bf16_t* Ps = Vs + 256 * 72; LAS float* biasT = (LAS float*)(Ps + 128 * 168);
#pragma unroll
    for (int r = 0; r < 4; ++r) { const int unit = tid + 512 * r, dg = unit & 7, jx = unit >> 3; const int kp = qb * 128 - 128 + jx;
        u32x4 kv = (u32x4){0u, 0u, 0u, 0u}, vv = (u32x4){0u, 0u, 0u, 0u};
        if (kp >= 0) { const bf16_t* src = c.U + (size_t)(b * PL + kp) * NU + U_KC + kvh * 64 + dg * 8; kv = *(const u32x4*)src; vv = *(const u32x4*)(src + (U_VC - U_KC)); }
        *(LAS u32x4*)(Ks + jx * 72 + dg * 8) = kv; *(LAS u32x4*)(Vs + jx * 72 + dg * 8) = vv; }
    for (int idx = tid; idx < 4 * 129; idx += 512) { const int gq = idx / 129, d = idx % 129; biasT[gq * 132 + d] = c.in[15][T5_BUCKET[d] * 8 + kvh * 4 + gq]; }
    __syncthreads();
    const int jstart = (16 * w < 96) ? 16 * w : 96;
    const int i = 16 * w + fr;
    for (int gq = 0; gq < 4; ++gq) { const int hq = kvh * 4 + gq;
        const bf16_t* qrow = c.U + (size_t)(row0 + i) * NU + U_QC + hq * 64;
        const bf16x8 qa0 = *(const bf16x8*)(qrow + fq * 8), qa1 = *(const bf16x8*)(qrow + 32 + fq * 8);
        f32x4 acc[10];
#pragma unroll
        for (int nb = 0; nb < 10; ++nb) { acc[nb] = (f32x4){0.f, 0.f, 0.f, 0.f};
            const LAS bf16_t* kr = Ks + (jstart + 16 * nb + fr) * 72 + fq * 8;
            acc[nb] = __builtin_amdgcn_mfma_f32_16x16x32_bf16(*(const LAS bf16x8*)kr, qa0, acc[nb], 0, 0, 0);
            acc[nb] = __builtin_amdgcn_mfma_f32_16x16x32_bf16(*(const LAS bf16x8*)(kr + 32), qa1, acc[nb], 0, 0, 0); }
        const float sink = c.in[14][c.l * 8 + hq]; float m = sink;
#pragma unroll
        for (int nb = 0; nb < 10; ++nb)
#pragma unroll
            for (int e = 0; e < 4; ++e) { const int jx = jstart + 16 * nb + 4 * fq + e, dist = i + 128 - jx; const bool ok = dist >= 0 && dist <= 128 && (qb > 0 || jx >= 128);
                const int dc = dist < 0 ? 0 : (dist > 128 ? 128 : dist);
                const float lgt = ok ? acc[nb][e] * 0.125f + biasT[gq * 132 + dc] : -1e30f; acc[nb][e] = lgt; m = fmaxf(m, lgt); }
        m = fmaxf(m, __shfl_xor(m, 16)); m = fmaxf(m, __shfl_xor(m, 32));
        float s = 0.f;
#pragma unroll
        for (int nb = 0; nb < 10; ++nb)
#pragma unroll
            for (int e = 0; e < 4; ++e) { const float p = acc[nb][e] > -1e29f ? __expf(acc[nb][e] - m) : 0.f; acc[nb][e] = p; s += p; }
        s += __shfl_xor(s, 16); s += __shfl_xor(s, 32);
        const float inv = 1.f / (s + __expf(sink - m));
#pragma unroll
        for (int nb = 0; nb < 10; ++nb) { u32x2 o; o.x = pk2(acc[nb][0] * inv, acc[nb][1] * inv); o.y = pk2(acc[nb][2] * inv, acc[nb][3] * inv); *(LAS u32x2*)(Ps + i * 168 + 16 * nb + 4 * fq) = o; }
        f32x4 oa[4]; ZERO_ACC(oa, 4);
#pragma unroll
        for (int ks = 0; ks < 5; ++ks) { const bf16x8 a = *(const LAS bf16x8*)(Ps + i * 168 + ks * 32 + fq * 8);
#pragma unroll
            for (int nb = 0; nb < 4; ++nb) { const bf16x8 bb = tr_frag(Vs, 72, 16 * nb, jstart + 32 * ks, lane); oa[nb] = __builtin_amdgcn_mfma_f32_16x16x32_bf16(bb, a, oa[nb], 0, 0, 0); } }
        bf16_t* op = c.ABR + (size_t)(row0 + i) * KBR + 1536 + hq * 64 + 4 * fq;
#pragma unroll
        for (int nb = 0; nb < 4; ++nb) { u32x2 o; o.x = pk2(oa[nb][0], oa[nb][1]); o.y = pk2(oa[nb][2], oa[nb][3]); *(u32x2*)(op + 16 * nb) = o; }
    }
    __syncthreads();
}

__device__ __forceinline__ void copyp_tile(const Ctx& c, int b) {
    const int tid = otid();
    for (int idx = tid; idx < 3 * 1536; idx += 512) { const int r = idx / 1536, ch = idx % 1536;
        c.out[O_CONVP + ((size_t)(c.l * 8 + b) * 3 + r) * 1536 + ch] = bf2f(c.U[(size_t)(b * PL + PL - 3 + r) * NU + U_XBC + ch]); }
    for (int idx = tid; idx < 128 * 128; idx += 512) { const int j = idx >> 7, ch = idx & 127; const size_t ur = (size_t)(b * PL + PL - 128 + j) * NU;
        c.out[O_KP + ((size_t)(c.l * 8 + b) * 128 + j) * 128 + ch] = bf2f(c.U[ur + U_KC + ch]);
        c.out[O_VP + ((size_t)(c.l * 8 + b) * 128 + j) * 128 + ch] = bf2f(c.U[ur + U_VC + ch]); }
}

__device__ __forceinline__ void sret_tile(const Ctx& c, int item, LAS unsigned char* lds) {
    const int tid = otid(), w = tid >> 6;
    const int h = item & 3, b = item >> 2, row = MPR + b;
    LAS float* qS = (LAS float*)lds; LAS float* kS = qS + 128; LAS float* vS = kS + 128; LAS float* part = vS + 128; LAS float* red = part + 2048;
    const bf16_t* ur = c.U + (size_t)row * NU;
    if (tid < 64) { float cs, sn; rot_cs(PAST_POS, tid, cs, sn);
        const float ql = bf2f(ur[U_QR + h * 128 + tid]), qh = bf2f(ur[U_QR + h * 128 + 64 + tid]), kl = bf2f(ur[U_KR + h * 128 + tid]), kh = bf2f(ur[U_KR + h * 128 + 64 + tid]);
        qS[tid] = ql * cs - qh * sn; qS[64 + tid] = ql * sn + qh * cs; kS[tid] = (kl * cs - kh * sn) * 0.08838834764831845f; kS[64 + tid] = (kl * sn + kh * cs) * 0.08838834764831845f;
    } else if (tid < 192) vS[tid - 64] = bf2f(ur[U_VR + h * 128 + tid - 64]);
    __syncthreads();
    const int v4 = (tid & 31) * 4, dg = tid >> 5; const float gamma = 1.f - exp2f(-5.f - (float)h); const f32x4 vv = *(const LAS f32x4*)(vS + v4);
    const size_t base = ((size_t)(c.l * 128 + b) * 4 + h) * 16384; const float* sin_ = c.in[2] + base; float* sout = c.out + O_RETS + base;
    f32x4 sv[8];
#pragma unroll
    for (int dd = 0; dd < 8; ++dd) sv[dd] = __builtin_nontemporal_load((const f32x4*)(sin_ + (dg * 8 + dd) * 128 + v4));
    f32x4 o = (f32x4){0.f, 0.f, 0.f, 0.f};
#pragma unroll
    for (int dd = 0; dd < 8; ++dd) { const int d = dg * 8 + dd; const f32x4 sn = sv[dd] * gamma + vv * kS[d]; __builtin_nontemporal_store(sn, (f32x4*)(sout + d * 128 + v4)); o += sn * qS[d]; }
    *(LAS f32x4*)(part + dg * 128 + v4) = o;
    __syncthreads();
    float ov = 0.f;
    if (tid < 128) {
#pragma unroll
        for (int k = 0; k < 16; ++k) ov += part[k * 128 + tid];
        const float s = wave_sum(ov); if ((tid & 63) == 0) red[w] = s; }
    __syncthreads();
    const float mean = (red[0] + red[1]) * (1.f / 128.f); const float dv = ov - mean;
    if (tid < 128) { const float s = wave_sum(dv * dv); if ((tid & 63) == 0) red[2 + w] = s; }
    __syncthreads();
    if (tid < 128) { const float rstd = rsqrtf((red[2] + red[3]) * (1.f / 128.f) + EPS); const float gt = siluf_(bf2f(ur[U_GR + h * 128 + tid]));
        c.ABR[(size_t)row * KBR + h * 128 + tid] = (bf16_t)f2bf(dv * rstd * gt); }
    __syncthreads();
}

__device__ __forceinline__ void sssd_tile(const Ctx& c, int item, LAS unsigned char* lds) {
    const int tid = otid(), w = tid >> 6;
    const int g = item & 1, b = item >> 1, row = MPR + b;
    LAS float* xS = (LAS float*)lds; LAS float* BS = xS + 512; LAS float* CS = BS + 128; LAS float* dtv = CS + 128; LAS float* red = dtv + 8;
    const bf16_t* ur = c.U + (size_t)row * NU;
    for (int ch = tid; ch < 768; ch += 512) { const int cb = ch < 512 ? g * 512 + ch : (ch < 640 ? 1024 + g * 128 + (ch - 512) : 1280 + g * 128 + (ch - 640));
        const float* cw = c.in[8] + (size_t)c.l * 4 * 1536 + cb; const float* sc = c.in[4] + (size_t)(c.l * 128 + b) * 3 * 1536 + cb;
        float a = c.in[9][c.l * 1536 + cb] + cw[0] * sc[0] + cw[1536] * sc[1536] + cw[3072] * sc[3072] + cw[4608] * bf2f(ur[U_XBC + cb]);
        xS[ch] = siluf_(a); }
    if (tid < 8) dtv[tid] = softplusf_(bf2f(ur[U_DT + g * 8 + tid]) + c.in[10][c.l * 16 + g * 8 + tid]);
    __syncthreads();
    const int s4 = (tid & 31) * 4, pg = tid >> 5; const f32x4 B4 = *(const LAS f32x4*)(BS + s4), C4 = *(const LAS f32x4*)(CS + s4);
    float ysq = 0.f;
#pragma unroll 2
    for (int hl = 0; hl < 8; ++hl) { const int h = g * 8 + hl; const float dt = dtv[hl], dA = __expf(dt * -__expf(c.in[11][c.l * 16 + h]));
        const size_t base = ((size_t)(c.l * 128 + b) * 16 + h) * 8192; const float* hin = c.in[3] + base; float* hout = c.out + O_SSMS + base;
        f32x4 hv[4];
#pragma unroll
        for (int k = 0; k < 4; ++k) hv[k] = __builtin_nontemporal_load((const f32x4*)(hin + (pg * 4 + k) * 128 + s4));
        float yk[4];
#pragma unroll
        for (int k = 0; k < 4; ++k) { const int p = pg * 4 + k; const f32x4 hn = hv[k] * dA + B4 * (dt * xS[hl * 64 + p]); __builtin_nontemporal_store(hn, (f32x4*)(hout + p * 128 + s4));
            yk[k] = (hn[0] * C4[0] + hn[1] * C4[1]) + (hn[2] * C4[2] + hn[3] * C4[3]); }
#pragma unroll
        for (int o = 1; o < 32; o <<= 1) {
#pragma unroll
            for (int k = 0; k < 4; ++k) yk[k] += __shfl_xor(yk[k], o); }
        if ((tid & 31) == 0) { const float dsk = c.in[12][c.l * 16 + h];
            const u32x2 zv = *(const u32x2*)(ur + U_Z + h * 64 + pg * 4); const float zz[4] = {lo16(zv.x), hi16(zv.x), lo16(zv.y), hi16(zv.y)}; float y[4];
#pragma unroll
            for (int k = 0; k < 4; ++k) { y[k] = (yk[k] + dsk * xS[hl * 64 + pg * 4 + k]) * siluf_(zz[k]); ysq += y[k] * y[k]; }
            u32x2 o; o.x = pk2(y[0], y[1]); o.y = pk2(y[2], y[3]); *(u32x2*)(c.ABR + (size_t)row * KBR + 512 + h * 64 + pg * 4) = o; }
    }
    { const float s = wave_sum(ysq); if ((tid & 63) == 0) red[w] = s; }
    __syncthreads();
    if (tid == 0) { float a = 0.f;
#pragma unroll
        for (int k = 0; k < 8; ++k) a += red[k];
        c.RSTD[row * 2 + g] = rsqrtf(a * (1.f / 512.f) + EPS); }
    __syncthreads();
}

__device__ __forceinline__ void sswa_tile(const Ctx& c, int b, LAS unsigned char* lds) {
    const int tid = otid(), w = tid >> 6, lane = tid & 63, row = MPR + b;
    LAS float* qS = (LAS float*)lds; LAS float* knew = qS + 512; LAS float* vnew = knew + 128; LAS float* pS = vnew + 128;
    const bf16_t* ur = c.U + (size_t)row * NU;
    qS[tid] = bf2f(ur[U_QC + tid]);
    if (tid < 128) knew[tid] = bf2f(ur[U_KC + tid]); else if (tid < 256) vnew[tid - 128] = bf2f(ur[U_VC + tid - 128]);
    __syncthreads();
    const int hq = w, kvh = w >> 2;
    const float* kc = c.in[5] + (size_t)(c.l * 128 + b) * 128 * 128 + kvh * 64; const float* vc = c.in[6] + (size_t)(c.l * 128 + b) * 128 * 128 + kvh * 64;
    float d0 = 0.f, d1 = 0.f, dn = 0.f;
#pragma unroll 4
    for (int d4 = 0; d4 < 16; ++d4) { const f32x4 q = *(const LAS f32x4*)(qS + hq * 64 + d4 * 4), k0 = *(const f32x4*)(kc + (size_t)lane * 128 + d4 * 4), k1 = *(const f32x4*)(kc + (size_t)(lane + 64) * 128 + d4 * 4), kn = *(const LAS f32x4*)(knew + kvh * 64 + d4 * 4);
        d0 += q[0] * k0[0] + q[1] * k0[1] + q[2] * k0[2] + q[3] * k0[3]; d1 += q[0] * k1[0] + q[1] * k1[1] + q[2] * k1[2] + q[3] * k1[3]; dn += q[0] * kn[0] + q[1] * kn[1] + q[2] * kn[2] + q[3] * kn[3]; }
    const float* rb = c.in[15];
    const float l0 = d0 * 0.125f + rb[T5_BUCKET[128 - lane] * 8 + hq], l1 = d1 * 0.125f + rb[T5_BUCKET[64 - lane] * 8 + hq], ln = dn * 0.125f + rb[hq], sink = c.in[14][c.l * 8 + hq];
    const float m = fmaxf(fmaxf(wave_max(fmaxf(l0, l1)), ln), sink);
    const float p0 = __expf(l0 - m), p1 = __expf(l1 - m), pn = __expf(ln - m);
    const float inv = 1.f / (wave_sum(p0 + p1) + pn + __expf(sink - m));
    pS[hq * 132 + lane] = p0 * inv; pS[hq * 132 + 64 + lane] = p1 * inv; if (lane == 0) pS[hq * 132 + 128] = pn * inv;
    __syncthreads();
    float o = pS[hq * 132 + 128] * vnew[kvh * 64 + lane];
#pragma unroll 8
    for (int j = 0; j < 128; ++j) o += pS[hq * 132 + j] * vc[(size_t)j * 128 + lane];
    c.ABR[(size_t)row * KBR + 1536 + hq * 64 + lane] = (bf16_t)f2bf(o);
    const size_t sb = (size_t)(c.l * 128 + b) * 128 * 128; const float* kin = c.in[5] + sb; const float* vin = c.in[6] + sb;
    for (int idx = tid; idx < 128 * 128; idx += 512) { const int j = idx >> 7, ch = idx & 127;
        c.out[O_KS + sb + idx] = j < 127 ? kin[idx + 128] : knew[ch]; c.out[O_VS + sb + idx] = j < 127 ? vin[idx + 128] : vnew[ch]; }
    const size_t cbs = (size_t)(c.l * 128 + b) * 3 * 1536;
    for (int ch = tid; ch < 1536; ch += 512) { c.out[O_CONVS + cbs + ch] = c.in[4][cbs + 1536 + ch]; c.out[O_CONVS + cbs + 1536 + ch] = c.in[4][cbs + 3072 + ch]; c.out[O_CONVS + cbs + 3072 + ch] = bf2f(ur[U_XBC + ch]); }
    __syncthreads();
}

__device__ __forceinline__ void scan_phase(const Ctx& c) {
    const int gt = blockIdx.x * 512 + otid(), NT = gridDim.x * 512;
    for (int i = gt; i < 8 * 4 * 4096; i += NT) { const int e4 = i & 4095, bh = i >> 12, h = bh & 3;
        const float cdec = __expf(__logf(1.f - exp2f(-5.f - (float)h)) * 128.f);
        float* p = c.KV + (size_t)bh * 16 * 16384 + e4 * 4; f32x4 run = (f32x4){0.f, 0.f, 0.f, 0.f}; f32x4 t[16];
#pragma unroll
        for (int n = 0; n < 16; ++n) t[n] = *(const f32x4*)(p + n * 16384);
#pragma unroll
        for (int n = 0; n < 16; ++n) { *(f32x4*)(p + n * 16384) = run; run = run * cdec + t[n]; }
        *(f32x4*)(c.out + O_RETP + ((size_t)c.l * 32 + bh) * 16384 + e4 * 4) = run; }
    for (int i = gt; i < 8 * 16 * 2048; i += NT) { const int e4 = i & 2047, bh = i >> 11, h = bh & 15, b = bh >> 4;
        f32x4 run = (f32x4){0.f, 0.f, 0.f, 0.f}; f32x4 t[16]; float dec[16];
#pragma unroll
        for (int n = 0; n < 16; ++n) { t[n] = *(const f32x4*)(c.ST + ((size_t)((b * 16 + n) * 16 + h)) * 8192 + e4 * 4); dec[n] = __expf(c.CSL[(b * 16 + n) * 16 + h]); }
#pragma unroll
        for (int n = 0; n < 16; ++n) { *(f32x4*)(c.ST + ((size_t)((b * 16 + n) * 16 + h)) * 8192 + e4 * 4) = run; run = run * dec[n] + t[n]; }
        *(f32x4*)(c.out + O_SSMP + ((size_t)c.l * 128 + bh) * 8192 + e4 * 4) = run; }
}

#define XB_TMO      128
#define XB_XCNT(j)  (256  + 64 * (j))
#define XB_XSUB(j)  (1280 + 64 * (j))
#define XB_XGEN(j)  (2304 + 64 * (j))
#define XB_TOP      3328
#define XB_TOPGEN   3392
#define XCD_BAR_WORDS 3456
#define XB_SPIN_CAP (1u << 22)
__device__ __forceinline__ unsigned xb_ld(unsigned* p)              { return __hip_atomic_load(p, __ATOMIC_RELAXED, __HIP_MEMORY_SCOPE_AGENT); }
__device__ __forceinline__ unsigned xb_add(unsigned* p, unsigned v) { return __hip_atomic_fetch_add(p, v, __ATOMIC_RELAXED, __HIP_MEMORY_SCOPE_AGENT); }
__device__ __forceinline__ unsigned xb_xcc_id() { return (unsigned)__builtin_amdgcn_s_getreg((3 << 11) | 20) & 0xFu; }
#define XB_SPIN(cond, bar) do { unsigned _sp = 0; while (cond) { __builtin_amdgcn_s_sleep(1); \
    if ((++_sp & 255u) == 0u) { if (xb_ld(&(bar)[XB_TMO])) break; if (_sp > XB_SPIN_CAP) { atomicAdd(&(bar)[XB_TMO], 1u); break; } } } } while (0)
struct XcdBarrier { unsigned* bar; unsigned x; volatile LAS unsigned* st; };
__device__ __forceinline__ XcdBarrier xcd_barrier_post(unsigned* bar, volatile LAS unsigned* st) {
    XcdBarrier b; b.bar = bar; b.x = xb_xcc_id(); b.st = st;
    if (threadIdx.x == 0) (void)xb_add(&bar[XB_XCNT(b.x)], 1u);
    return b;
}
__device__ __forceinline__ void xcd_barrier_complete(unsigned* bar, unsigned x, unsigned& nloc, unsigned& nx) {
    const unsigned G = gridDim.x * gridDim.y * gridDim.z;
    unsigned sum, cnt, mine, sp = 0u;
    for (;;) {
        sum = 0u; cnt = 0u; mine = 0u;
#pragma unroll
        for (unsigned j = 0; j < 16; ++j) { const unsigned c = xb_ld(&bar[XB_XCNT(j)]); sum += c; cnt += (c > 0u) ? 1u : 0u; mine = (j == x) ? c : mine; }
        if (sum == G) break;
        __builtin_amdgcn_s_sleep(1);
        if ((++sp & 255u) == 0u) { if (xb_ld(&bar[XB_TMO])) break; if (sp > XB_SPIN_CAP) { atomicAdd(&bar[XB_TMO], 1u); break; } }
    }
    nloc = mine > 0u ? mine : 1u; nx = cnt > 0u ? cnt : 1u;
}
__device__ __forceinline__ void xcd_barrier(const XcdBarrier& b) {
    asm volatile("s_waitcnt vmcnt(0)" ::: "memory");
    __syncthreads();
    if (threadIdx.x == 0) {
        unsigned* bar = b.bar;
        __builtin_amdgcn_s_waitcnt(0);
        unsigned nloc = b.st[0], nx = b.st[1];
        if (nloc == 0u) { xcd_barrier_complete(bar, b.x, nloc, nx); b.st[0] = nloc; b.st[1] = nx; }
        const unsigned old = xb_add(&bar[XB_XSUB(b.x)], 1u);
        const unsigned gen = old / nloc;
        if (old + 1u == (gen + 1u) * nloc) {
            __builtin_amdgcn_fence(__ATOMIC_RELEASE, "agent");
            asm volatile("s_waitcnt vmcnt(0)" ::: "memory");
            const unsigned og = xb_add(&bar[XB_TOP], 1u);
            const unsigned tg = og / nx;
            if (og + 1u == (tg + 1u) * nx) xb_add(&bar[XB_TOPGEN], 1u);
            else XB_SPIN(xb_ld(&bar[XB_TOPGEN]) == tg, bar);
            __builtin_amdgcn_fence(__ATOMIC_ACQUIRE, "agent");
            xb_add(&bar[XB_XGEN(b.x)], 1u);
            asm volatile("s_waitcnt vmcnt(0)" ::: "memory");
        } else {
            XB_SPIN(xb_ld(&bar[XB_XGEN(b.x)]) == gen, bar);
            __builtin_amdgcn_fence(__ATOMIC_ACQUIRE, "agent");
            asm volatile("s_waitcnt vmcnt(0)" ::: "memory");
        }
    }
    __syncthreads();
}

constexpr int N_PHASES = 1 + NLAYER * 10;
#ifndef DISMASK
#define DISMASK 0
#endif
#ifndef REPMASK
#define REPMASK 0
#endif
#define DIS(bit, stmt) do { if (!((DISMASK) & (bit))) { stmt; } } while (0)
__global__ void __launch_bounds__(512, 2) mega_fwd(Args a) {
    extern __shared__ __attribute__((aligned(16))) unsigned char lds_raw[];
    LAS unsigned char* lds = (LAS unsigned char*)lds_raw;
    cg::grid_group grid = cg::this_grid();
    Ctx c; c.in = a.in; c.out = a.out; c.ws = a.ws;
    c.XB = (bf16_t*)(a.ws + WS_XB); c.XF = (float*)(a.ws + WS_XF); c.U = (bf16_t*)(a.ws + WS_U); c.H = (bf16_t*)(a.ws + WS_U); c.ABR = (bf16_t*)(a.ws + WS_ABR);
    c.MIX = (float*)(a.ws + WS_MIX); c.MIXB = (bf16_t*)(a.ws + WS_MIXB); c.KV = (float*)(a.ws + WS_KV); c.ST = (float*)(a.ws + WS_ST); c.CSL = (float*)(a.ws + WS_CSL); c.RSTD = (float*)(a.ws + WS_RSTD); c.XBCC = (bf16_t*)(a.ws + WS_XBCC);
    const int G = gridDim.x, bx = blockIdx.x;
    volatile LAS unsigned* bst = (volatile LAS unsigned*)(lds + LDS_BYTES - 16);
    if (threadIdx.x < 4) bst[threadIdx.x] = 0u;
    __syncthreads();
    XcdBarrier xbar = xcd_barrier_post((unsigned*)(a.ws + WS_CTL), bst);
    int rep = 0;
    for (int ph = a.ph_lo; ph < a.ph_hi; ++ph) {
        if (ph == 0) { c.l = 0; DIS(1024, prologue(c, lds)); }
        else {
            const int l = (ph - 1) / 10, s = (ph - 1) % 10; c.l = l;
            if (s == 0) {
                pg8::Gemm g{c.XB, wl(a.ws, l, OFF_WIN), MP, NU, DM, DM, DM}; pg8::StaticOrder S; S.init(MP, NU, G, bx);
                EpiBf16 E{c.U, NU}; DIS(2048, (pg8::gemm_phase<EpiBf16, true>(lds, g, S, E)));
            } else if (s == 1) {
                for (int it = bx; it < 1928; it += G) {
                    if (it < 256) { DIS(1, swa_tile(c, it, lds)); }
                    else if (it < 512) { DIS(2, ssd1_tile(c, it - 256, lds)); }
                    else if (it < 1024) { DIS(4, ret1_tile(c, it - 512, lds)); }
                    else if (it < 1536) { DIS(8, sret_tile(c, it - 1024, lds)); }
                    else if (it < 1792) { DIS(16, sssd_tile(c, it - 1536, lds)); }
                    else if (it < 1920) { DIS(32, sswa_tile(c, it - 1792, lds)); }
                    else { DIS(64, copyp_tile(c, it - 1920)); }
                }
            } else if (s == 2) { DIS(512, scan_phase(c)); }
            else if (s == 3) {
                for (int it = bx; it < 768; it += G) { if (it < 256) { DIS(128, ssd2_tile(c, it, lds)); } else { DIS(256, ret2_tile(c, it - 256, lds)); } }
            } else if (s == 4) {
                for (int br = 0; br < 4; ++br) {
                    pg8::Gemm g{c.ABR + br * 512, wl(a.ws, l, OFF_WBR) + br * 512, MP, DM, 512, KBR, KBR}; pg8::StaticOrder S; S.init(MP, DM, G, bx);
                    EpiBranch E{c.U, c.RSTD, c.MIX, c.MIXB, br}; DIS(4096, (pg8::gemm_phase<EpiBranch, true>(lds, g, S, E)));
                }
            } else if (s == 5 || s == 8) {
                pg8::Gemm g{s == 5 ? c.MIXB : c.H, wl(a.ws, l, s == 5 ? OFF_WOUT : OFF_WDN), MP, DM, s == 5 ? DM : DFF, s == 5 ? DM : DFF, s == 5 ? DM : DFF}; pg8::StaticOrder S; S.init(MP, DM, G, bx);
                EpiRes E{c.XF, c.MIX}; DIS(8192, (pg8::gemm_phase<EpiRes, true>(lds, g, S, E)));
            } else if (s == 6 || s == 9) {
                const bool fin = (s == 9 && l == NLAYER - 1);
                DIS(32768, ln_phase(c, c.in[s == 6 ? 20 : 22] + l * DM, c.in[s == 6 ? 21 : 23] + l * DM, fin));
            } else {
                pg8::Gemm g{c.XB, wl(a.ws, l, OFF_WGU), MP, 2 * DFF, DM, DM, DM}; pg8::StaticOrder S; S.init(MP, 2 * DFF, G, bx);
                EpiGU E{c.H}; DIS(16384, (pg8::gemm_phase<EpiGU, true>(lds, g, S, E)));
            }
        }
        if (ph + 1 < a.ph_hi) { if (ph == 0 && rep == 0) grid.sync(); else xcd_barrier(xbar); }
        if (REPMASK) { const int sidx = ph == 0 ? 10 : (ph - 1) % 10; if (((REPMASK) >> sidx & 1) && rep == 0) { rep = 1; --ph; } else rep = 0; }
    }
}

#ifndef MK_PER_PHASE
#define MK_PER_PHASE 0
#endif
extern "C" void kernel_launch(void* const* d_in, const int* in_sizes, int n_in, void* d_out, int out_size, void* d_ws, size_t ws_size, hipStream_t stream) {
    static int grid = 0;
    if (grid == 0) {
        if (n_in != 27 || (size_t)out_size != O_END || ws_size < WS_END) { fprintf(stderr, "kernel_launch: unexpected shapes: n_in %d out %d (want %zu) ws %zu (want %zu)\n", n_in, out_size, (size_t)O_END, ws_size, (size_t)WS_END); grid = -1; return; }
        int dev = 0, cus = 0, per_cu = 0;
        (void)hipGetDevice(&dev); (void)hipDeviceGetAttribute(&cus, hipDeviceAttributeMultiprocessorCount, dev);
        if (hipFuncSetAttribute((const void*)mega_fwd, hipFuncAttributeMaxDynamicSharedMemorySize, LDS_BYTES) != hipSuccess) { fprintf(stderr, "kernel_launch: hipFuncSetAttribute failed\n"); grid = -1; return; }
        if (hipOccupancyMaxActiveBlocksPerMultiprocessor(&per_cu, (const void*)mega_fwd, 512, LDS_BYTES) != hipSuccess || per_cu < 1) { fprintf(stderr, "kernel_launch: occupancy query says %d\n", per_cu); per_cu = 1; }
        (void)hipGetLastError();
        grid = cus * per_cu;
    }
    if (grid < 0) return;
    if (hipMemsetAsync((char*)d_ws + WS_CTL, 0, CTL_BYTES, stream) != hipSuccess) { fprintf(stderr, "kernel_launch: memset failed\n"); return; }
    Args a{};
    for (int i = 0; i < 27; ++i) a.in[i] = (const float*)d_in[i];
    a.out = (float*)d_out; a.ws = (unsigned char*)d_ws;
#if MK_PER_PHASE
    for (int ph = 0; ph < N_PHASES; ++ph) { a.ph_lo = ph; a.ph_hi = ph + 1; hipLaunchKernelGGL(mega_fwd, dim3(grid), dim3(512), LDS_BYTES, stream, a); }
#else
    a.ph_lo = 0; a.ph_hi = N_PHASES;
    void* args[] = {&a};
    hipError_t e = hipLaunchCooperativeKernel((const void*)mega_fwd, dim3(grid), dim3(512), args, LDS_BYTES, stream);
    if (e != hipSuccess) fprintf(stderr, "cooperative launch failed: %s (grid %d)\n", hipGetErrorString(e), grid);
#endif
}
```

```cpp
#include <hip/hip_runtime.h>
#include <hip/hip_cooperative_groups.h>
#include <cstdio>
#include <cstdint>
namespace cg = cooperative_groups;

#define LAS __attribute__((address_space(3)))
typedef unsigned short bf16_t;
typedef short bf16x8 __attribute__((ext_vector_type(8)));
typedef float f32x4 __attribute__((ext_vector_type(4)));
typedef float f32x2 __attribute__((ext_vector_type(2)));
typedef unsigned u32x4 __attribute__((ext_vector_type(4)));
typedef unsigned u32x2 __attribute__((ext_vector_type(2)));

constexpr int DM = 1024, NLAYER = 4;
constexpr int PB = 8, PL = 2048, MPR = PB * PL;
constexpr int SB = 128;
constexpr int MREAL = MPR + SB;
constexpr int MP = 16640;
constexpr int NIN = 8464, NU = 8704;
constexpr int DFF = 2816;
constexpr int KBR = 2048;
constexpr int U_QR = 0, U_KR = 512, U_VR = 1024, U_GR = 1536, U_Z = 2048, U_XBC = 3072, U_QC = 4608, U_KC = 5120, U_VC = 5248, U_GATE = 5376, U_DT = 8448;
constexpr float ALPHA = 1.681792830507429f;
constexpr float EPS = 1e-5f;
constexpr float PAST_POS = 8192.f;

constexpr size_t SZ_WIN = (size_t)NU * DM * 2, SZ_WBR = (size_t)DM * KBR * 2, SZ_WOUT = (size_t)DM * DM * 2, SZ_WGU = (size_t)2 * DFF * DM * 2, SZ_WDN = (size_t)DM * DFF * 2;
constexpr size_t SZ_WL = SZ_WIN + SZ_WBR + SZ_WOUT + SZ_WGU + SZ_WDN;
constexpr size_t WS_W = 0;
constexpr size_t WS_XB = WS_W + NLAYER * SZ_WL;
constexpr size_t WS_XF = WS_XB + (size_t)MP * DM * 2;
constexpr size_t WS_U = WS_XF + (size_t)MP * DM * 4;
constexpr size_t WS_ABR = WS_U + (size_t)MP * NU * 2;
constexpr size_t WS_MIX = WS_ABR + (size_t)MP * KBR * 2;
constexpr size_t WS_MIXB = WS_MIX + (size_t)MP * DM * 4;
constexpr size_t WS_KV = WS_MIXB + (size_t)MP * DM * 2;
constexpr size_t WS_ST = WS_KV + (size_t)8 * 4 * 16 * 16384 * 4;
constexpr size_t WS_CSL = WS_ST + (size_t)8 * 16 * 16 * 8192 * 4;
constexpr size_t WS_RSTD = WS_CSL + 8192;
constexpr size_t WS_XBCC = WS_RSTD + (size_t)MP * 2 * 4;
constexpr size_t WS_CTL = WS_XBCC + (size_t)MPR * 1536 * 2;
constexpr size_t CTL_BYTES = 16384;
constexpr size_t WS_END = WS_CTL + CTL_BYTES;

constexpr size_t O_Y = 0;
constexpr size_t O_RETP = (size_t)MREAL * DM;
constexpr size_t O_SSMP = O_RETP + (size_t)4 * 8 * 4 * 16384;
constexpr size_t O_CONVP = O_SSMP + (size_t)4 * 8 * 16 * 8192;
constexpr size_t O_KP = O_CONVP + (size_t)4 * 8 * 3 * 1536;
constexpr size_t O_VP = O_KP + (size_t)4 * 8 * 128 * 128;
constexpr size_t O_RETS = O_VP + (size_t)4 * 8 * 128 * 128;
constexpr size_t O_SSMS = O_RETS + (size_t)4 * 128 * 4 * 16384;
constexpr size_t O_CONVS = O_SSMS + (size_t)4 * 128 * 16 * 8192;
constexpr size_t O_KS = O_CONVS + (size_t)4 * 128 * 3 * 1536;
constexpr size_t O_VS = O_KS + (size_t)4 * 128 * 128 * 128;
constexpr size_t O_END = O_VS + (size_t)4 * 128 * 128 * 128;

constexpr int LDS_BYTES = 147456;

__device__ const unsigned char T5_BUCKET[132] = {0, 1, 2, 3, 4, 5, 6, 7, 8, 9, 10, 11, 12, 13, 14, 15, 16, 16, 16, 17, 17, 18, 18, 18, 19, 19, 19, 20, 20, 20, 20, 21, 21, 21, 21, 22, 22, 22, 22, 22, 23, 23, 23, 23, 23, 23, 24, 24, 24, 24, 24, 24, 25, 25, 25, 25, 25, 25, 25, 26, 26, 26, 26, 26, 26, 26, 26, 27, 27, 27, 27, 27, 27, 27, 27, 27, 27, 28, 28, 28, 28, 28, 28, 28, 28, 28, 28, 29, 29, 29, 29, 29, 29, 29, 29, 29, 29, 29, 29, 30, 30, 30, 30, 30, 30, 30, 30, 30, 30, 30, 30, 30, 30, 31, 31, 31, 31, 31, 31, 31, 31, 31, 31, 31, 31, 31, 31, 31, 31, 31, 31, 31};

__device__ __forceinline__ int otid() { int t = threadIdx.x; asm volatile("" : "+v"(t)); return t; }
__device__ __forceinline__ float bf2f(unsigned short h) { return __uint_as_float(((unsigned)h) << 16); }
__device__ __forceinline__ unsigned f2bf(float f) { unsigned u = __float_as_uint(f); return (u + 0x7fffu + ((u >> 16) & 1u)) >> 16; }
__device__ __forceinline__ unsigned pk2(float lo, float hi) { return f2bf(lo) | (f2bf(hi) << 16); }
__device__ __forceinline__ float lo16(unsigned v) { return __uint_as_float(v << 16); }
__device__ __forceinline__ float hi16(unsigned v) { return __uint_as_float(v & 0xffff0000u); }
#define UNPACK8(v, f) do { f[0] = lo16((v).x); f[1] = hi16((v).x); f[2] = lo16((v).y); f[3] = hi16((v).y); f[4] = lo16((v).z); f[5] = hi16((v).z); f[6] = lo16((v).w); f[7] = hi16((v).w); } while (0)
__device__ __forceinline__ float sigmoidf_(float x) { return 1.f / (1.f + __expf(-x)); }
__device__ __forceinline__ float siluf_(float x) { return x / (1.f + __expf(-x)); }
__device__ __forceinline__ float softplusf_(float x) { return x > 20.f ? x : log1pf(__expf(x)); }
__device__ __forceinline__ float wave_sum(float v) {
#pragma unroll
    for (int o = 1; o < 64; o <<= 1) v += __shfl_xor(v, o);
    return v;
}
__device__ __forceinline__ float wave_max(float v) {
#pragma unroll
    for (int o = 1; o < 64; o <<= 1) v = fmaxf(v, __shfl_xor(v, o));
    return v;
}
__device__ __forceinline__ void rot_cs(float pos, int i, float& c, float& s) {
    const float ci = __builtin_amdgcn_exp2f(-(float)i * 0.20762050593046014f) * 0.15915494309189535f;
    float rev = pos * ci; rev = rev - floorf(rev);
    s = __builtin_amdgcn_sinf(rev); c = __builtin_amdgcn_cosf(rev);
}

namespace pg8 {
constexpr int BM = 256, BK = 64, HALF = 128, HTB = HALF * BK * 2, STAGE_BYTES = 8 * HTB, NXCD = 8, WGM = 8;
__host__ __device__ __forceinline__ int lds_byte(int r, int c) { const int st = (r >> 4) * 2 + (c >> 5), rr = r & 15, cc = c & 31, ob = rr * 64 + cc * 2; return st * 1024 + (ob ^ (((ob >> 9) & 1) << 5)); }
__host__ __device__ __forceinline__ void stage_rc(int b, int& R, int& C) { const int st = b / 1024, sb = b % 1024, swz = sb ^ (((sb >> 9) & 1) << 5); R = (st >> 1) * 16 + swz / 64; C = (st & 1) * 32 + (swz % 64) / 2; }
__host__ __device__ __forceinline__ int perm32(int rho) { const int n = rho >> 4, i = rho & 15; return 8 * (i >> 2) + 4 * n + (i & 3); }
struct Unit { int pm, pn; };
struct Gemm { const bf16_t* A; const bf16_t* Bt; int M, N, K, lda, ldb; };
struct StaticOrder {
    int nM, nN, nwg, G, c;
    __device__ void init(int M, int N, int G_, int c_) { nM = M / BM; nN = N / BM; nwg = nM * nN; G = G_; c = c_; }
    __device__ bool next(int i, Unit& u) const {
        const long L = (long)i * G + c; if (L >= nwg) return false;
        int wgid = (int)L; { const int q = nwg / NXCD, r = nwg % NXCD, xcd = wgid % NXCD, off = wgid / NXCD; wgid = (xcd < r ? xcd * (q + 1) : r * (q + 1) + (xcd - r) * q) + off; }
        const int nig = WGM * nN, gid = wgid / nig, fm = gid * WGM, gsz = (nM - fm) < WGM ? (nM - fm) : WGM;
        u.pm = fm + ((wgid % nig) % gsz); u.pn = (wgid % nig) / gsz; return true;
    }
};
template <class Epi, bool ALIGN_EPI>
__device__ __forceinline__ void gemm_phase(LAS unsigned char* lds, const Gemm g, const StaticOrder& S, const Epi& E) {
    const int tid = otid(), wid = __builtin_amdgcn_readfirstlane(tid >> 6), lane = tid & 63, wr = wid >> 2, wc = wid & 3, fr = lane & 15, fq = lane >> 4;
    const int K = g.K, nt = K / BK;
    unsigned voffA[2], voffB[2];
#pragma unroll
    for (int i = 0; i < 2; ++i) { int R, C; stage_rc(tid * 16 + i * 8192, R, C); const int Rb = (R & ~31) + perm32(R & 31);
        voffA[i] = (unsigned)(R * g.lda + C) * 2u; voffB[i] = (unsigned)(Rb * g.ldb + C) * 2u; }
    const size_t kstep = (size_t)(BK * 2);
    const size_t hstepA = (size_t)HALF * g.lda * 2, hstepB = (size_t)HALF * g.ldb * 2;
    const size_t tstepA = 2 * hstepA, tstepB = 2 * hstepB;
    const unsigned ldsw = (unsigned)wid * 1024u;
    const int aoff = lds_byte(wr * 64 + fr, fq * 8), boff = lds_byte(wc * 32 + fr, fq * 8);
#define PG8_SA(b, h) (((b) * 2 + (h)) * HTB)
#define PG8_SB(b, h) ((4 + (b) * 2 + (h)) * HTB)
#define PG8_STAGE(bufoff, gbase, voff) do { _Pragma("unroll") for (int _i = 0; _i < 2; ++_i) \
        __builtin_amdgcn_global_load_lds((const unsigned*)((const char*)(gbase) + (voff)[_i]), (LAS unsigned*)(lds + (bufoff) + ldsw + _i * 8192), 16, 0, 0); } while (0)
#define PG8_LDA(dst, b, h) do { _Pragma("unroll") for (int m = 0; m < 4; ++m) _Pragma("unroll") for (int k = 0; k < 2; ++k) dst[m][k] = *(const LAS bf16x8*)(lds + PG8_SA(b, h) + aoff + m * 2048 + k * 1024); } while (0)
#define PG8_LDB(dst, b, h) do { _Pragma("unroll") for (int n = 0; n < 2; ++n) _Pragma("unroll") for (int k = 0; k < 2; ++k) dst[n][k] = *(const LAS bf16x8*)(lds + PG8_SB(b, h) + boff + n * 2048 + k * 1024); } while (0)
#define PG8_MMA(ai, bj, At, Bt) do { __builtin_amdgcn_s_setprio(1); _Pragma("unroll") for (int m = 0; m < 4; ++m) _Pragma("unroll") for (int n = 0; n < 2; ++n) _Pragma("unroll") for (int k = 0; k < 2; ++k) \
        acc[ai][bj][m][n] = __builtin_amdgcn_mfma_f32_16x16x32_bf16(Bt[n][k], At[m][k], acc[ai][bj][m][n], 0, 0, 0); __builtin_amdgcn_s_setprio(0); } while (0)
#define PG8_WAIT_V(n) asm volatile("s_waitcnt vmcnt(" #n ")" ::: "memory")
#define PG8_WAIT_L(n) asm volatile("s_waitcnt lgkmcnt(" #n ")" ::: "memory")
#define PG8_BAR __builtin_amdgcn_s_barrier()
#define PG8_SCHED __builtin_amdgcn_sched_barrier(0)
    Unit cur, nxt; int ui = 0;
    if (!S.next(0, cur)) return;
    f32x4 acc[2][2][4][2];
#pragma unroll
    for (int a = 0; a < 2; ++a)
#pragma unroll
        for (int b = 0; b < 2; ++b)
#pragma unroll
            for (int m = 0; m < 4; ++m)
#pragma unroll
                for (int n = 0; n < 2; ++n) acc[a][b][m][n] = (f32x4){0.f, 0.f, 0.f, 0.f};
    bf16x8 At[4][2], B0[2][2], B1[2][2];
    const char* cA = (const char*)g.A + (size_t)cur.pm * tstepA; const char* cB = (const char*)g.Bt + (size_t)cur.pn * tstepB;
    PG8_STAGE(PG8_SB(0, 0), cB, voffB); PG8_STAGE(PG8_SB(0, 1), cB + hstepB, voffB); PG8_STAGE(PG8_SA(0, 0), cA, voffA); PG8_STAGE(PG8_SA(0, 1), cA + hstepA, voffA);
    if (wr == 1) PG8_BAR;
    PG8_WAIT_V(2); PG8_BAR;
    PG8_STAGE(PG8_SB(1, 0), cB + kstep, voffB); PG8_STAGE(PG8_SA(1, 0), cA + kstep, voffA); PG8_STAGE(PG8_SB(1, 1), cB + hstepB + kstep, voffB);
    PG8_WAIT_V(6); PG8_BAR;
    for (;;) {
        const bool has_next = S.next(ui + 1, nxt);
        const char* nA = has_next ? (const char*)g.A + (size_t)nxt.pm * tstepA : cA; const char* nB = has_next ? (const char*)g.Bt + (size_t)nxt.pn * tstepB : cB;
        for (int t = 0; t < nt; t += 2) {
            const bool last = (t == nt - 2);
            const char* a1 = cA + (size_t)(t + 1) * kstep;
            const char* a2 = last ? nA : cA + (size_t)(t + 2) * kstep; const char* b2 = last ? nB : cB + (size_t)(t + 2) * kstep;
            const char* a3 = a2 + kstep; const char* b3 = b2 + kstep;
            PG8_LDB(B0, 0, 0); PG8_LDB(B1, 0, 1); PG8_SCHED; PG8_LDA(At, 0, 0); PG8_STAGE(PG8_SA(1, 1), a1 + hstepA, voffA);
            PG8_WAIT_V(8); PG8_WAIT_L(0); PG8_BAR; PG8_MMA(0, 0, At, B0); PG8_MMA(0, 1, At, B1); PG8_BAR; PG8_SCHED;
            PG8_LDA(At, 0, 1); PG8_STAGE(PG8_SB(0, 0), b2, voffB); PG8_STAGE(PG8_SB(0, 1), b2 + hstepB, voffB); PG8_STAGE(PG8_SA(0, 0), a2, voffA);
            PG8_WAIT_V(8); PG8_WAIT_L(0); PG8_BAR; PG8_MMA(1, 0, At, B0); PG8_MMA(1, 1, At, B1); PG8_BAR; PG8_SCHED;
            PG8_LDB(B0, 1, 0); PG8_LDB(B1, 1, 1); PG8_SCHED; PG8_LDA(At, 1, 0); PG8_STAGE(PG8_SA(0, 1), a2 + hstepA, voffA);
            PG8_WAIT_V(8); PG8_WAIT_L(0); PG8_BAR; PG8_MMA(0, 0, At, B0); PG8_MMA(0, 1, At, B1); PG8_BAR; PG8_SCHED;
            PG8_LDA(At, 1, 1); PG8_STAGE(PG8_SB(1, 0), b3, voffB); PG8_STAGE(PG8_SB(1, 1), b3 + hstepB, voffB); PG8_STAGE(PG8_SA(1, 0), a3, voffA);
            PG8_WAIT_V(8); PG8_WAIT_L(0); PG8_BAR; PG8_MMA(1, 0, At, B0); PG8_MMA(1, 1, At, B1); PG8_BAR; PG8_SCHED;
        }
        if constexpr (ALIGN_EPI) { if (wr == 0) PG8_BAR; }
        E(acc, cur, wr, wc, fr, fq);
        if (!has_next) break;
#pragma unroll
        for (int a = 0; a < 2; ++a)
#pragma unroll
            for (int b = 0; b < 2; ++b)
#pragma unroll
                for (int m = 0; m < 4; ++m)
#pragma unroll
                    for (int n = 0; n < 2; ++n) acc[a][b][m][n] = (f32x4){0.f, 0.f, 0.f, 0.f};
        cur = nxt; cA = nA; cB = nB; ++ui;
        if constexpr (ALIGN_EPI) { if (wr == 1) PG8_BAR; }
    }
    PG8_WAIT_V(0);
    if constexpr (!ALIGN_EPI) { if (wr == 0) PG8_BAR; }
    PG8_BAR;
#undef PG8_SA
#undef PG8_SB
#undef PG8_STAGE
#undef PG8_LDA
#undef PG8_LDB
#undef PG8_MMA
#undef PG8_WAIT_V
#undef PG8_WAIT_L
#undef PG8_BAR
#undef PG8_SCHED
}
}

struct EpiBf16 {
    bf16_t* O; int ldc;
    __device__ __forceinline__ void operator()(const f32x4 (&acc)[2][2][4][2], const pg8::Unit& u, int wr, int wc, int fr, int fq) const {
        const int row0 = u.pm * 256 + wr * 64 + fr, col0 = u.pn * 256 + wc * 32 + 8 * fq;
#pragma unroll
        for (int ai = 0; ai < 2; ++ai)
#pragma unroll
            for (int m = 0; m < 4; ++m) { bf16_t* rowp = O + (size_t)(row0 + ai * 128 + m * 16) * ldc + col0;
#pragma unroll
                for (int bj = 0; bj < 2; ++bj) { const f32x4 v0 = acc[ai][bj][m][0], v1 = acc[ai][bj][m][1];
                    u32x4 w; w.x = pk2(v0[0], v0[1]); w.y = pk2(v0[2], v0[3]); w.z = pk2(v1[0], v1[1]); w.w = pk2(v1[2], v1[3]);
                    *(u32x4*)(rowp + bj * 128) = w; } }
    }
};
struct EpiGU {
    bf16_t* H;
    __device__ __forceinline__ void operator()(const f32x4 (&acc)[2][2][4][2], const pg8::Unit& u, int wr, int wc, int fr, int fq) const {
        const int row0 = u.pm * 256 + wr * 64 + fr, col0 = u.pn * 256 + wc * 32 + 8 * fq;
#pragma unroll
        for (int ai = 0; ai < 2; ++ai)
#pragma unroll
            for (int m = 0; m < 4; ++m) { bf16_t* rowp = H + (size_t)(row0 + ai * 128 + m * 16) * DFF + (col0 >> 1);
#pragma unroll
                for (int bj = 0; bj < 2; ++bj) { const f32x4 v0 = acc[ai][bj][m][0], v1 = acc[ai][bj][m][1];
                    u32x2 w; w.x = pk2(siluf_(v0[0]) * v1[0], siluf_(v0[1]) * v1[1]); w.y = pk2(siluf_(v0[2]) * v1[2], siluf_(v0[3]) * v1[3]);
                    *(u32x2*)(rowp + bj * 64) = w; } }
    }
};
struct EpiRes {
    const float* X; float* V;
    __device__ __forceinline__ void operator()(const f32x4 (&acc)[2][2][4][2], const pg8::Unit& u, int wr, int wc, int fr, int fq) const {
        const int row0 = u.pm * 256 + wr * 64 + fr, col0 = u.pn * 256 + wc * 32 + 8 * fq;
#pragma unroll
        for (int ai = 0; ai < 2; ++ai)
#pragma unroll
            for (int m = 0; m < 4; ++m) { const size_t off = (size_t)(row0 + ai * 128 + m * 16) * DM + col0;
#pragma unroll
                for (int bj = 0; bj < 2; ++bj) {
                    const f32x4 x0 = *(const f32x4*)(X + off + bj * 128), x1 = *(const f32x4*)(X + off + bj * 128 + 4);
                    *(f32x4*)(V + off + bj * 128) = x0 * ALPHA + acc[ai][bj][m][0]; *(f32x4*)(V + off + bj * 128 + 4) = x1 * ALPHA + acc[ai][bj][m][1]; } }
    }
};
struct EpiBranch {
    const bf16_t* U; const float* RSTD; float* MIX; bf16_t* MIXB; int br;
    __device__ __forceinline__ void operator()(const f32x4 (&acc)[2][2][4][2], const pg8::Unit& u, int wr, int wc, int fr, int fq) const {
        const int row0 = u.pm * 256 + wr * 64 + fr, col0 = u.pn * 256 + wc * 32 + 8 * fq;
        const int gcol = U_GATE + (br == 0 ? 0 : (br == 3 ? 2048 : 1024));
#pragma unroll
        for (int ai = 0; ai < 2; ++ai)
#pragma unroll
            for (int m = 0; m < 4; ++m) { const int row = row0 + ai * 128 + m * 16; const size_t off = (size_t)row * DM + col0;
                float rs = 1.f; if (br == 1) rs = RSTD[row * 2]; else if (br == 2) rs = RSTD[row * 2 + 1];
#pragma unroll
                for (int bj = 0; bj < 2; ++bj) {
                    const u32x4 gv = *(const u32x4*)(U + (size_t)row * NU + gcol + col0 + bj * 128); float gf[8]; UNPACK8(gv, gf);
                    f32x4 v0 = acc[ai][bj][m][0], v1 = acc[ai][bj][m][1];
#pragma unroll
                    for (int e = 0; e < 4; ++e) { v0[e] *= rs * sigmoidf_(gf[e]); v1[e] *= rs * sigmoidf_(gf[4 + e]); }
                    float* mp = MIX + off + bj * 128;
                    if (br != 0) { v0 += *(const f32x4*)mp; v1 += *(const f32x4*)(mp + 4); }
                    if (br != 3) { *(f32x4*)mp = v0; *(f32x4*)(mp + 4) = v1; }
                    else { u32x4 w; w.x = pk2(v0[0], v0[1]); w.y = pk2(v0[2], v0[3]); w.z = pk2(v1[0], v1[1]); w.w = pk2(v1[2], v1[3]); *(u32x4*)(MIXB + off + bj * 128) = w; } } }
    }
};

struct Args { const float* in[27]; float* out; unsigned char* ws; int ph_lo, ph_hi; };
struct Ctx {
    const float* const* in; float* out; unsigned char* ws;
    bf16_t *XB, *U, *ABR, *MIXB, *H, *XBCC; float *XF, *MIX, *KV, *ST, *CSL, *RSTD;
    int l;
};

template <int NB, int KS>
__device__ __forceinline__ void mm_strip(f32x4 (&acc)[NB], const LAS unsigned char* A, int lda_b, const LAS unsigned char* Bt, int ldb_b, int fr, int fq) {
#pragma unroll
    for (int ks = 0; ks < KS; ++ks) {
        const bf16x8 a = *(const LAS bf16x8*)(A + fr * lda_b + ks * 64 + fq * 16);
#pragma unroll
        for (int nb = 0; nb < NB; ++nb) {
            const bf16x8 b = *(const LAS bf16x8*)(Bt + (nb * 16 + fr) * ldb_b + ks * 64 + fq * 16);
            acc[nb] = __builtin_amdgcn_mfma_f32_16x16x32_bf16(b, a, acc[nb], 0, 0, 0);
        }
    }
}

__device__ __forceinline__ int dest_row(int mode, int n) {
    if (mode == 1) return n < 4608 ? n : (n < 4624 ? 8448 + (n - 4608) : n - 16);
    if (mode == 2) return 8 * (n >> 2) + (n & 3);
    if (mode == 3) return 8 * (n >> 2) + 4 + (n & 3);
    return n;
}
__device__ __forceinline__ void transpose_item(const float* W, int K, int N, bf16_t* WT, int ldk, int koff, int mode, const float* kscale, LAS float* scr, int item, int lane) {
    const int nblk = (N + 31) / 32, kb = item / nblk, nb = item % nblk, k0 = 64 * kb, n0 = 32 * nb;
    const int nn = n0 + (lane & 31);
#pragma unroll 8
    for (int i = 0; i < 32; ++i) { const int kk = 2 * i + (lane >> 5); float v = 0.f; if (nn < N) { v = W[(size_t)(k0 + kk) * N + nn]; if (kscale) v *= kscale[k0 + kk]; } scr[kk * 33 + (lane & 31)] = v; }
    asm volatile("s_waitcnt lgkmcnt(0)" ::: "memory");
    const int c = lane & 7;
#pragma unroll
    for (int j = 0; j < 4; ++j) { const int n = (lane >> 3) + 8 * j; const LAS float* s = scr + (8 * c) * 33 + n;
        u32x4 o; o.x = pk2(s[0 * 33], s[1 * 33]); o.y = pk2(s[2 * 33], s[3 * 33]); o.z = pk2(s[4 * 33], s[5 * 33]); o.w = pk2(s[6 * 33], s[7 * 33]);
        if (n0 + n < N) *(u32x4*)(WT + (size_t)dest_row(mode, n0 + n) * ldk + koff + k0 + 8 * c) = o; }
    asm volatile("s_waitcnt lgkmcnt(0)" ::: "memory");
}
__device__ __forceinline__ bf16_t* wl(unsigned char* ws, int l, size_t off) { return (bf16_t*)(ws + WS_W + (size_t)l * SZ_WL + off); }
constexpr size_t OFF_WIN = 0, OFF_WBR = SZ_WIN, OFF_WOUT = OFF_WBR + SZ_WBR, OFF_WGU = OFF_WOUT + SZ_WOUT, OFF_WDN = OFF_WGU + SZ_WGU;

__device__ __forceinline__ void prologue(const Ctx& c, LAS unsigned char* lds) {
    const int tid = otid(), wave = tid >> 6, lane = tid & 63;
    const int G = gridDim.x, gw = blockIdx.x * 8 + wave, NGW = G * 8;
    LAS float* scr = (LAS float*)(lds + wave * 16384);
    constexpr int I_IN = 16 * 265, I_R = 8 * 32, I_S = 16 * 32, I_O = 16 * 32, I_G = 16 * 88, I_D = 44 * 32;
    constexpr int I_LAYER = I_IN + I_R + I_S + I_R + I_O + I_G + I_G + I_D;
    for (int it = gw; it < NLAYER * I_LAYER; it += NGW) {
        const int l = it / I_LAYER; int r = it % I_LAYER;
        if (r < I_IN) { transpose_item(c.in[7] + (size_t)l * DM * NIN, DM, NIN, wl(c.ws, l, OFF_WIN), DM, 0, 1, nullptr, scr, r, lane); continue; } r -= I_IN;
        if (r < I_R) { transpose_item(c.in[16] + (size_t)l * 512 * DM, 512, DM, wl(c.ws, l, OFF_WBR), KBR, 0, 0, nullptr, scr, r, lane); continue; } r -= I_R;
        if (r < I_S) { transpose_item(c.in[17] + (size_t)l * 1024 * DM, 1024, DM, wl(c.ws, l, OFF_WBR), KBR, 512, 0, c.in[13] + l * 1024, scr, r, lane); continue; } r -= I_S;
        if (r < I_R) { transpose_item(c.in[18] + (size_t)l * 512 * DM, 512, DM, wl(c.ws, l, OFF_WBR), KBR, 1536, 0, nullptr, scr, r, lane); continue; } r -= I_R;
        if (r < I_O) { transpose_item(c.in[19] + (size_t)l * DM * DM, DM, DM, wl(c.ws, l, OFF_WOUT), DM, 0, 0, nullptr, scr, r, lane); continue; } r -= I_O;
        if (r < I_G) { transpose_item(c.in[24] + (size_t)l * DM * DFF, DM, DFF, wl(c.ws, l, OFF_WGU), DM, 0, 2, nullptr, scr, r, lane); continue; } r -= I_G;
        if (r < I_G) { transpose_item(c.in[25] + (size_t)l * DM * DFF, DM, DFF, wl(c.ws, l, OFF_WGU), DM, 0, 3, nullptr, scr, r, lane); continue; } r -= I_G;
        transpose_item(c.in[26] + (size_t)l * DFF * DM, DFF, DM, wl(c.ws, l, OFF_WDN), DFF, 0, 0, nullptr, scr, r, lane);
    }
    const int gt = blockIdx.x * 512 + tid, NT = G * 512;
    for (int i = gt; i < NLAYER * 240 * 128; i += NT) { const int l = i / (240 * 128), r = i % (240 * 128); *(u32x4*)(wl(c.ws, l, OFF_WIN) + (size_t)(NIN + r / 128) * DM + (r % 128) * 8) = (u32x4){0u, 0u, 0u, 0u}; }
    for (int i = gt; i < MP * (DM / 4); i += NT) { const int row = i >> 8, c4 = (i & 255) * 4;
        f32x4 v = (f32x4){0.f, 0.f, 0.f, 0.f};
        if (row < MPR) v = *(const f32x4*)(c.in[0] + (size_t)row * DM + c4); else if (row < MREAL) v = *(const f32x4*)(c.in[1] + (size_t)(row - MPR) * DM + c4);
        *(f32x4*)(c.XF + (size_t)row * DM + c4) = v; u32x2 w; w.x = pk2(v[0], v[1]); w.y = pk2(v[2], v[3]); *(u32x2*)(c.XB + (size_t)row * DM + c4) = w; }
}

__device__ __forceinline__ void ln_phase(const Ctx& c, const float* g, const float* b, bool final_out) {
    const int tid = otid(), wave = tid >> 6, lane = tid & 63;
    const int gw = blockIdx.x * 8 + wave, NGW = gridDim.x * 8;
    for (int row = gw; row < MREAL; row += NGW) {
        const f32x4* xr = (const f32x4*)(c.MIX + (size_t)row * DM) + lane;
        f32x4 v[4]; float s = 0.f;
#pragma unroll
        for (int j = 0; j < 4; ++j) { v[j] = xr[64 * j]; s += (v[j][0] + v[j][1]) + (v[j][2] + v[j][3]); }
        const float mean = wave_sum(s) * (1.f / DM); float s2 = 0.f;
#pragma unroll
        for (int j = 0; j < 4; ++j) { v[j] = v[j] - mean; s2 += (v[j][0] * v[j][0] + v[j][1] * v[j][1]) + (v[j][2] * v[j][2] + v[j][3] * v[j][3]); }
        const float rstd = rsqrtf(wave_sum(s2) * (1.f / DM) + EPS);
#pragma unroll
        for (int j = 0; j < 4; ++j) { const int col = (lane + 64 * j) * 4; const f32x4 gg = *(const f32x4*)(g + col), bb = *(const f32x4*)(b + col);
            const f32x4 o = v[j] * rstd * gg + bb;
            if (final_out) *(f32x4*)(c.out + O_Y + (size_t)row * DM + col) = o;
            else { *(f32x4*)(c.XF + (size_t)row * DM + col) = o; u32x2 w; w.x = pk2(o[0], o[1]); w.y = pk2(o[2], o[3]); *(u32x2*)(c.XB + (size_t)row * DM + col) = w; } }
    }
}

__device__ __forceinline__ void conv8(const Ctx& c, int row, int t, int cb, float (&o)[8]) {
    const float* cw = c.in[8] + (size_t)c.l * 4 * 1536 + cb; const float* cbias = c.in[9] + (size_t)c.l * 1536 + cb;
    { const f32x4 b0 = *(const f32x4*)cbias, b1 = *(const f32x4*)(cbias + 4); o[0] = b0[0]; o[1] = b0[1]; o[2] = b0[2]; o[3] = b0[3]; o[4] = b1[0]; o[5] = b1[1]; o[6] = b1[2]; o[7] = b1[3]; }
#pragma unroll
    for (int tau = 0; tau < 4; ++tau) {
        const int dt = tau - 3;
        if (t + dt >= 0) {
            const u32x4 xv = *(const u32x4*)(c.U + (size_t)(row + dt) * NU + U_XBC + cb); float xf[8]; UNPACK8(xv, xf);
            const f32x4 w0 = *(const f32x4*)(cw + tau * 1536), w1 = *(const f32x4*)(cw + tau * 1536 + 4);
            o[0] += w0[0] * xf[0]; o[1] += w0[1] * xf[1]; o[2] += w0[2] * xf[2]; o[3] += w0[3] * xf[3]; o[4] += w1[0] * xf[4]; o[5] += w1[1] * xf[5]; o[6] += w1[2] * xf[6]; o[7] += w1[3] * xf[7];
        }
    }
#pragma unroll
    for (int e = 0; e < 8; ++e) o[e] = siluf_(o[e]);
}
__device__ __forceinline__ void ssd_dtcs(const Ctx& c, int row0, int g, LAS float* dtS, LAS float* csS, int w, int lane, float* csl_out) {
    const int h = g * 8 + w;
    const float bias = c.in[10][c.l * 16 + h], a = -__expf(c.in[11][c.l * 16 + h]);
    const int j = 2 * lane;
    const float d0 = softplusf_(bf2f(c.U[(size_t)(row0 + j) * NU + U_DT + h]) + bias), d1 = softplusf_(bf2f(c.U[(size_t)(row0 + j + 1) * NU + U_DT + h]) + bias);
    const float v0 = d0 * a, v1 = d1 * a; float s = v0 + v1;
#pragma unroll
    for (int o = 1; o < 64; o <<= 1) { const float t = __shfl_up(s, o); if (lane >= o) s += t; }
    const float ex = s - (v0 + v1);
    dtS[w * 128 + j] = d0; dtS[w * 128 + j + 1] = d1; csS[w * 128 + j] = ex + v0; csS[w * 128 + j + 1] = s;
    if (csl_out && lane == 63) *csl_out = s;
}

constexpr int LD136 = 272;
typedef short s16x4 __attribute__((ext_vector_type(4)));
__device__ __forceinline__ bf16x8 tr_frag(const LAS bf16_t* T, int ld, int col0, int krow0, int lane) {
    const int g = lane >> 4, q = (lane & 15) >> 2, p = lane & 3;
    LAS s16x4* a0 = (LAS s16x4*)(T + (krow0 + 8 * g + q) * ld + col0 + 4 * p);
    const s16x4 lo = __builtin_amdgcn_ds_read_tr16_b64_v4i16(a0);
    const s16x4 hi = __builtin_amdgcn_ds_read_tr16_b64_v4i16(a0 + ld);
    return __builtin_shufflevector(lo, hi, 0, 1, 2, 3, 4, 5, 6, 7);
}
#define ZERO_ACC(a, n) _Pragma("unroll") for (int _z = 0; _z < (n); ++_z) a[_z] = (f32x4){0.f, 0.f, 0.f, 0.f}
#define PACK8(o, f) do { (o).x = pk2(f[0], f[1]); (o).y = pk2(f[2], f[3]); (o).z = pk2(f[4], f[5]); (o).w = pk2(f[6], f[7]); } while (0)

__device__ __forceinline__ void ret1_tile(const Ctx& c, int item, LAS unsigned char* lds) {
    const int tid = otid(), w = tid >> 6, lane = tid & 63, fr = lane & 15, fq = lane >> 4;
    const int n = item & 15, h = (item >> 4) & 3, b = item >> 6;
    const int row0 = b * PL + n * 128;
    const float lg = __logf(1.f - exp2f(-5.f - (float)h));
    LAS bf16_t* Ks = (LAS bf16_t*)lds; LAS bf16_t* Vs = Ks + 128 * 136;
#pragma unroll
    for (int r = 0; r < 2; ++r) { const int unit = tid + 512 * r, dg = unit & 7, j = unit >> 3;
        const bf16_t* src = c.U + (size_t)(row0 + j) * NU + U_KR + h * 128 + dg * 8;
        const u32x4 lo = *(const u32x4*)src, hi = *(const u32x4*)(src + 64); float fl[8], fh[8]; UNPACK8(lo, fl); UNPACK8(hi, fh);
        const float pos = (float)(n * 128 + j), sc = 0.08838834764831845f * __expf(lg * (float)(127 - j)); float k1[8], k2[8];
#pragma unroll
        for (int e = 0; e < 8; ++e) { float cs, sn; rot_cs(pos, dg * 8 + e, cs, sn); k1[e] = (fl[e] * cs - fh[e] * sn) * sc; k2[e] = (fl[e] * sn + fh[e] * cs) * sc; }
        u32x4 o; PACK8(o, k1); *(LAS u32x4*)(Ks + j * 136 + dg * 8) = o; PACK8(o, k2); *(LAS u32x4*)(Ks + j * 136 + 64 + dg * 8) = o; }
#pragma unroll
    for (int r = 0; r < 4; ++r) { const int unit = tid + 512 * r, vg = unit & 15, j = unit >> 4;
        *(LAS u32x4*)(Vs + j * 136 + vg * 8) = *(const u32x4*)(c.U + (size_t)(row0 + j) * NU + U_VR + h * 128 + vg * 8); }
    __syncthreads();
    f32x4 acc[8]; ZERO_ACC(acc, 8);
#pragma unroll
    for (int ks = 0; ks < 4; ++ks) { const bf16x8 a = tr_frag(Ks, 136, 16 * w, 32 * ks, lane);
#pragma unroll
        for (int nb = 0; nb < 8; ++nb) { const bf16x8 bb = tr_frag(Vs, 136, 16 * nb, 32 * ks, lane); acc[nb] = __builtin_amdgcn_mfma_f32_16x16x32_bf16(bb, a, acc[nb], 0, 0, 0); } }
    float* dst = c.KV + ((size_t)((b * 4 + h) * 16 + n)) * 16384 + (16 * w + fr) * 128 + 4 * fq;
#pragma unroll
    for (int nb = 0; nb < 8; ++nb) *(f32x4*)(dst + 16 * nb) = acc[nb];
    __syncthreads();
}

__device__ __forceinline__ void ret2_tile(const Ctx& c, int item, LAS unsigned char* lds) {
    const int tid = otid(), w = tid >> 6, lane = tid & 63, fr = lane & 15, fq = lane >> 4;
    const int n = item & 15, h = (item >> 4) & 3, b = item >> 6;
    const int row0 = b * PL + n * 128;
    const float lg = __logf(1.f - exp2f(-5.f - (float)h));
    LAS bf16_t* Qs = (LAS bf16_t*)lds; LAS bf16_t* Ks = Qs + 128 * 136; LAS bf16_t* Vs = Ks + 128 * 136; LAS bf16_t* Ss = Vs + 128 * 136;
#pragma unroll
    for (int r = 0; r < 2; ++r) { const int unit = tid + 512 * r, dg = unit & 7, j = unit >> 3;
        const bf16_t* qsrc = c.U + (size_t)(row0 + j) * NU + U_QR + h * 128 + dg * 8; const bf16_t* ksrc = qsrc + (U_KR - U_QR);
        const u32x4 qlo = *(const u32x4*)qsrc, qhi = *(const u32x4*)(qsrc + 64), klo = *(const u32x4*)ksrc, khi = *(const u32x4*)(ksrc + 64);
        float ql[8], qh[8], kl[8], kh[8]; UNPACK8(qlo, ql); UNPACK8(qhi, qh); UNPACK8(klo, kl); UNPACK8(khi, kh);
        const float pos = (float)(n * 128 + j); float q1[8], q2[8], k1[8], k2[8];
#pragma unroll
        for (int e = 0; e < 8; ++e) { float cs, sn; rot_cs(pos, dg * 8 + e, cs, sn);
            q1[e] = ql[e] * cs - qh[e] * sn; q2[e] = ql[e] * sn + qh[e] * cs;
            k1[e] = (kl[e] * cs - kh[e] * sn) * 0.08838834764831845f; k2[e] = (kl[e] * sn + kh[e] * cs) * 0.08838834764831845f; }
        u32x4 o;
        PACK8(o, q1); *(LAS u32x4*)(Qs + j * 136 + dg * 8) = o; PACK8(o, q2); *(LAS u32x4*)(Qs + j * 136 + 64 + dg * 8) = o;
        PACK8(o, k1); *(LAS u32x4*)(Ks + j * 136 + dg * 8) = o; PACK8(o, k2); *(LAS u32x4*)(Ks + j * 136 + 64 + dg * 8) = o; }
    { const float* sb = c.KV + ((size_t)((b * 4 + h) * 16 + n)) * 16384;
#pragma unroll
      for (int r = 0; r < 4; ++r) { const int unit = tid + 512 * r, vg = unit & 15, j = unit >> 4;
          *(LAS u32x4*)(Vs + j * 136 + vg * 8) = *(const u32x4*)(c.U + (size_t)(row0 + j) * NU + U_VR + h * 128 + vg * 8);
          const f32x4 s0 = *(const f32x4*)(sb + j * 128 + vg * 8), s1 = *(const f32x4*)(sb + j * 128 + vg * 8 + 4);
          u32x4 o; o.x = pk2(s0[0], s0[1]); o.y = pk2(s0[2], s0[3]); o.z = pk2(s1[0], s1[1]); o.w = pk2(s1[2], s1[3]); *(LAS u32x4*)(Ss + j * 136 + vg * 8) = o; } }
    __syncthreads();
    f32x4 acc[8]; ZERO_ACC(acc, 8);
    mm_strip<8, 4>(acc, (const LAS unsigned char*)Qs + w * 16 * LD136, LD136, (const LAS unsigned char*)Ks, LD136, fr, fq);
    const int i = 16 * w + fr;
    __syncthreads();
#pragma unroll
    for (int nb = 0; nb < 8; ++nb) { float p[4];
#pragma unroll
        for (int e = 0; e < 4; ++e) { const int dl = i - (16 * nb + 4 * fq + e); p[e] = dl >= 0 ? acc[nb][e] * __expf(lg * (float)dl) : 0.f; }
        u32x2 o; o.x = pk2(p[0], p[1]); o.y = pk2(p[2], p[3]); *(LAS u32x2*)(Ks + i * 136 + 16 * nb + 4 * fq) = o; }
    f32x4 a2[8], a3[8]; ZERO_ACC(a2, 8); ZERO_ACC(a3, 8);
#pragma unroll
    for (int ks = 0; ks < 4; ++ks) {
        const bf16x8 ap = *(const LAS bf16x8*)(Ks + i * 136 + ks * 32 + fq * 8), aq = *(const LAS bf16x8*)(Qs + i * 136 + ks * 32 + fq * 8);
#pragma unroll
        for (int nb = 0; nb < 8; ++nb) { const bf16x8 bv = tr_frag(Vs, 136, 16 * nb, 32 * ks, lane), bs = tr_frag(Ss, 136, 16 * nb, 32 * ks, lane);
            a2[nb] = __builtin_amdgcn_mfma_f32_16x16x32_bf16(bv, ap, a2[nb], 0, 0, 0); a3[nb] = __builtin_amdgcn_mfma_f32_16x16x32_bf16(bs, aq, a3[nb], 0, 0, 0); } }
    const float qd = __expf(lg * (float)(i + 1)); float s = 0.f;
#pragma unroll
    for (int nb = 0; nb < 8; ++nb) { a2[nb] = a2[nb] + a3[nb] * qd; s += (a2[nb][0] + a2[nb][1]) + (a2[nb][2] + a2[nb][3]); }
    s += __shfl_xor(s, 16); s += __shfl_xor(s, 32);
    const float mean = s * (1.f / 128.f); float q = 0.f;
#pragma unroll
    for (int nb = 0; nb < 8; ++nb) { a2[nb] = a2[nb] - mean; q += (a2[nb][0] * a2[nb][0] + a2[nb][1] * a2[nb][1]) + (a2[nb][2] * a2[nb][2] + a2[nb][3] * a2[nb][3]); }
    q += __shfl_xor(q, 16); q += __shfl_xor(q, 32);
    const float rstd = rsqrtf(q * (1.f / 128.f) + EPS);
    const bf16_t* gp = c.U + (size_t)(row0 + i) * NU + U_GR + h * 128 + 4 * fq; bf16_t* op = c.ABR + (size_t)(row0 + i) * KBR + h * 128 + 4 * fq;
#pragma unroll
    for (int nb = 0; nb < 8; ++nb) { const u32x2 gv = *(const u32x2*)(gp + 16 * nb);
        const float g0 = siluf_(lo16(gv.x)), g1 = siluf_(hi16(gv.x)), g2 = siluf_(lo16(gv.y)), g3 = siluf_(hi16(gv.y));
        u32x2 o; o.x = pk2(a2[nb][0] * rstd * g0, a2[nb][1] * rstd * g1); o.y = pk2(a2[nb][2] * rstd * g2, a2[nb][3] * rstd * g3); *(u32x2*)(op + 16 * nb) = o; }
    __syncthreads();
}

__device__ __forceinline__ void ssd1_tile(const Ctx& c, int item, LAS unsigned char* lds) {
    const int tid = otid(), w = tid >> 6, lane = tid & 63, fr = lane & 15, fq = lane >> 4;
    const int g = item & 1, n = (item >> 1) & 15, b = item >> 5;
    const int row0 = b * PL + n * 128;
    LAS bf16_t* Bs = (LAS bf16_t*)lds; LAS bf16_t* Xs = Bs + 128 * 136; LAS float* dtS = (LAS float*)(Xs + 128 * 72); LAS float* csS = dtS + 1024;
    ssd_dtcs(c, row0, g, dtS, csS, w, lane, c.CSL + (b * 16 + n) * 16 + g * 8 + w);
#pragma unroll 2
    for (int r = 0; r < 24; ++r) { const int unit = tid + 512 * r, cg = unit % 96, j = unit / 96; float o[8];
        const int cl = cg * 8, cb = cl < 512 ? g * 512 + cl : (cl < 640 ? 1024 + g * 128 + (cl - 512) : 1280 + g * 128 + (cl - 640));
        conv8(c, row0 + j, n * 128 + j, cb, o);
        u32x4 pk; PACK8(pk, o); *(u32x4*)(c.XBCC + (size_t)(row0 + j) * 1536 + cb) = pk;
        if (cl >= 512 && cl < 640) *(LAS u32x4*)(Bs + j * 136 + (cl - 512)) = pk; }
    __syncthreads();
    for (int hl = 0; hl < 8; ++hl) { const int h = g * 8 + hl;
        const float csl = csS[hl * 128 + 127];
#pragma unroll
        for (int r = 0; r < 2; ++r) { const int unit = tid + 512 * r, pg = unit & 7, j = unit >> 3; float o[8];
            const u32x4 xv = *(const u32x4*)(c.XBCC + (size_t)(row0 + j) * 1536 + h * 64 + pg * 8); UNPACK8(xv, o);
            const float sc = dtS[hl * 128 + j] * __expf(csl - csS[hl * 128 + j]);
#pragma unroll
            for (int e = 0; e < 8; ++e) o[e] *= sc;
            u32x4 pk; PACK8(pk, o); *(LAS u32x4*)(Xs + j * 72 + pg * 8) = pk; }
        __syncthreads();
        const int strip = w & 3, nh = w >> 2;
        f32x4 acc[4]; ZERO_ACC(acc, 4);
#pragma unroll
        for (int ks = 0; ks < 4; ++ks) { const bf16x8 a = tr_frag(Xs, 72, 16 * strip, 32 * ks, lane);
#pragma unroll
            for (int nb = 0; nb < 4; ++nb) { const bf16x8 bb = tr_frag(Bs, 136, nh * 64 + 16 * nb, 32 * ks, lane); acc[nb] = __builtin_amdgcn_mfma_f32_16x16x32_bf16(bb, a, acc[nb], 0, 0, 0); } }
        float* dst = c.ST + ((size_t)(((b * 16 + n) * 16 + h) * 64 + 16 * strip + fr)) * 128 + nh * 64 + 4 * fq;
#pragma unroll
        for (int nb = 0; nb < 4; ++nb) *(f32x4*)(dst + 16 * nb) = acc[nb];
        __syncthreads();
    }
}

__device__ __forceinline__ void ssd2_tile(const Ctx& c, int item, LAS unsigned char* lds) {
    const int tid = otid(), w = tid >> 6, lane = tid & 63, fr = lane & 15, fq = lane >> 4;
    const int g = item & 1, n = (item >> 1) & 15, b = item >> 5;
    const int row0 = b * PL + n * 128;
    LAS bf16_t* Cs = (LAS bf16_t*)lds; LAS bf16_t* Bs = Cs + 128 * 136; LAS bf16_t* Xs = Bs + 128 * 136; LAS bf16_t* Ss = Xs + 128 * 72;
    LAS float* dtS = (LAS float*)(Ss + 64 * 136); LAS float* csS = dtS + 1024;
    ssd_dtcs(c, row0, g, dtS, csS, w, lane, nullptr);
#pragma unroll
    for (int r = 0; r < 4; ++r) { const int unit = tid + 512 * r, sg = unit & 15, j = unit >> 4; const bf16_t* src = c.XBCC + (size_t)(row0 + j) * 1536 + 1024 + g * 128 + sg * 8;
        *(LAS u32x4*)(Bs + j * 136 + sg * 8) = *(const u32x4*)src; *(LAS u32x4*)(Cs + j * 136 + sg * 8) = *(const u32x4*)(src + 256); }
    __syncthreads();
    f32x4 cb[8]; ZERO_ACC(cb, 8);
    mm_strip<8, 4>(cb, (const LAS unsigned char*)Cs + w * 16 * LD136, LD136, (const LAS unsigned char*)Bs, LD136, fr, fq);
    __syncthreads();
    const int i = 16 * w + fr; float sumsq = 0.f;
    for (int hl = 0; hl < 8; ++hl) { const int h = g * 8 + hl;
#pragma unroll
        for (int r = 0; r < 2; ++r) { const int unit = tid + 512 * r, pg = unit & 7, j = unit >> 3;
            *(LAS u32x4*)(Xs + j * 72 + pg * 8) = *(const u32x4*)(c.XBCC + (size_t)(row0 + j) * 1536 + h * 64 + pg * 8); }
        { const float* sb = c.ST + ((size_t)(((b * 16 + n) * 16 + h) * 64)) * 128;
#pragma unroll
          for (int r = 0; r < 2; ++r) { const int unit = tid + 512 * r, s8 = unit & 15, p = unit >> 4;
              const f32x4 v0 = *(const f32x4*)(sb + p * 128 + s8 * 8), v1 = *(const f32x4*)(sb + p * 128 + s8 * 8 + 4);
              u32x4 pk; pk.x = pk2(v0[0], v0[1]); pk.y = pk2(v0[2], v0[3]); pk.z = pk2(v1[0], v1[1]); pk.w = pk2(v1[2], v1[3]); *(LAS u32x4*)(Ss + p * 136 + s8 * 8) = pk; } }
        const float csi = csS[hl * 128 + i];
#pragma unroll
        for (int nb = 0; nb < 8; ++nb) { const f32x4 csj = *(const LAS f32x4*)(csS + hl * 128 + 16 * nb + 4 * fq), dtj = *(const LAS f32x4*)(dtS + hl * 128 + 16 * nb + 4 * fq); float p[4];
#pragma unroll
            for (int e = 0; e < 4; ++e) { const int j = 16 * nb + 4 * fq + e; p[e] = (i >= j) ? cb[nb][e] * __expf(csi - csj[e]) * dtj[e] : 0.f; }
            u32x2 o; o.x = pk2(p[0], p[1]); o.y = pk2(p[2], p[3]); *(LAS u32x2*)(Bs + i * 136 + 16 * nb + 4 * fq) = o; }
        __syncthreads();
        f32x4 yi[4], yc[4]; ZERO_ACC(yi, 4); ZERO_ACC(yc, 4);
#pragma unroll
        for (int ks = 0; ks < 4; ++ks) { const bf16x8 aw = *(const LAS bf16x8*)(Bs + i * 136 + ks * 32 + fq * 8), ac = *(const LAS bf16x8*)(Cs + i * 136 + ks * 32 + fq * 8);
#pragma unroll
            for (int nb = 0; nb < 4; ++nb) { const bf16x8 bx = tr_frag(Xs, 72, 16 * nb, 32 * ks, lane), bs = *(const LAS bf16x8*)(Ss + (16 * nb + fr) * 136 + ks * 32 + fq * 8);
                yi[nb] = __builtin_amdgcn_mfma_f32_16x16x32_bf16(bx, aw, yi[nb], 0, 0, 0); yc[nb] = __builtin_amdgcn_mfma_f32_16x16x32_bf16(bs, ac, yc[nb], 0, 0, 0); } }
        const float ecs = __expf(csi), dsk = c.in[12][c.l * 16 + h];
        const bf16_t* zp = c.U + (size_t)(row0 + i) * NU + U_Z + h * 64 + 4 * fq; bf16_t* op = c.ABR + (size_t)(row0 + i) * KBR + 512 + h * 64 + 4 * fq;
#pragma unroll
        for (int nb = 0; nb < 4; ++nb) { const u32x2 zv = *(const u32x2*)(zp + 16 * nb), xv = *(const LAS u32x2*)(Xs + i * 72 + 16 * nb + 4 * fq);
            const float zz[4] = {lo16(zv.x), hi16(zv.x), lo16(zv.y), hi16(zv.y)}, xx[4] = {lo16(xv.x), hi16(xv.x), lo16(xv.y), hi16(xv.y)}; float y[4];
#pragma unroll
            for (int e = 0; e < 4; ++e) { y[e] = (yi[nb][e] + ecs * yc[nb][e] + dsk * xx[e]) * siluf_(zz[e]); sumsq += y[e] * y[e]; }
            u32x2 o; o.x = pk2(y[0], y[1]); o.y = pk2(y[2], y[3]); *(u32x2*)(op + 16 * nb) = o; }
        __syncthreads();
    }
    sumsq += __shfl_xor(sumsq, 16); sumsq += __shfl_xor(sumsq, 32);
    if (fq == 0) c.RSTD[(row0 + i) * 2 + g] = rsqrtf(sumsq * (1.f / 512.f) + EPS);
}

__device__ __forceinline__ void swa_tile(const Ctx& c, int item, LAS unsigned char* lds) {
    const int tid = otid(), w = tid >> 6, lane = tid & 63, fr = lane & 15, fq = lane >> 4;
    const int kvh = item & 1, qb = (item >> 1) & 15, b = item >> 5;
    const int row0 = b * PL + qb * 128;
    LAS bf16_t* Ks = (LAS bf16_t*)lds; LAS bf16_t* Vs = Ks + 256 * 72; LAS bf16_t* Ps = Vs + 256 * 72; LAS float* biasT = (LAS float*)(Ps + 128 * 168);
#pragma unroll
    for (int r = 0; r < 4; ++r) { const int unit = tid + 512 * r, dg = unit & 7, jx = unit >> 3; const int kp = qb * 128 - 128 + jx;
        u32x4 kv = (u32x4){0u, 0u, 0u, 0u}, vv = (u32x4){0u, 0u, 0u, 0u};
        if (kp >= 0) { const bf16_t* src = c.U + (size_t)(b * PL + kp) * NU + U_KC + kvh * 64 + dg * 8; kv = *(const u32x4*)src; vv = *(const u32x4*)(src + (U_VC - U_KC)); }
        *(LAS u32x4*)(Ks + jx * 72 + dg * 8) = kv; *(LAS u32x4*)(Vs + jx * 72 + dg * 8) = vv; }
    for (int idx = tid; idx < 4 * 129; idx += 512) { const int gq = idx / 129, d = idx % 129; biasT[gq * 132 + d] = c.in[15][T5_BUCKET[d] * 8 + kvh * 4 + gq]; }
    __syncthreads();
    const int jstart = (16 * w < 96) ? 16 * w : 96;
    const int i = 16 * w + fr;
    for (int gq = 0; gq < 4; ++gq) { const int hq = kvh * 4 + gq;
        const bf16_t* qrow = c.U + (size_t)(row0 + i) * NU + U_QC + hq * 64;
        const bf16x8 qa0 = *(const bf16x8*)(qrow + fq * 8), qa1 = *(const bf16x8*)(qrow + 32 + fq * 8);
        f32x4 acc[10];
#pragma unroll
        for (int nb = 0; nb < 10; ++nb) { acc[nb] = (f32x4){0.f, 0.f, 0.f, 0.f};
            const LAS bf16_t* kr = Ks + (jstart + 16 * nb + fr) * 72 + fq * 8;
            acc[nb] = __builtin_amdgcn_mfma_f32_16x16x32_bf16(*(const LAS bf16x8*)kr, qa0, acc[nb], 0, 0, 0);
            acc[nb] = __builtin_amdgcn_mfma_f32_16x16x32_bf16(*(const LAS bf16x8*)(kr + 32), qa1, acc[nb], 0, 0, 0); }
        const float sink = c.in[14][c.l * 8 + hq]; float m = sink;
#pragma unroll
        for (int nb = 0; nb < 10; ++nb)
#pragma unroll
            for (int e = 0; e < 4; ++e) { const int jx = jstart + 16 * nb + 4 * fq + e, dist = i + 128 - jx; const bool ok = dist >= 0 && dist <= 128 && (qb > 0 || jx >= 128);
                const int dc = dist < 0 ? 0 : (dist > 128 ? 128 : dist);
                const float lgt = ok ? acc[nb][e] * 0.125f + biasT[gq * 132 + dc] : -1e30f; acc[nb][e] = lgt; m = fmaxf(m, lgt); }
        m = fmaxf(m, __shfl_xor(m, 16)); m = fmaxf(m, __shfl_xor(m, 32));
        float s = 0.f;
#pragma unroll
        for (int nb = 0; nb < 10; ++nb)
#pragma unroll
            for (int e = 0; e < 4; ++e) { const float p = acc[nb][e] > -1e29f ? __expf(acc[nb][e] - m) : 0.f; acc[nb][e] = p; s += p; }
        s += __shfl_xor(s, 16); s += __shfl_xor(s, 32);
        const float inv = 1.f / (s + __expf(sink - m));
#pragma unroll
        for (int nb = 0; nb < 10; ++nb) { u32x2 o; o.x = pk2(acc[nb][0] * inv, acc[nb][1] * inv); o.y = pk2(acc[nb][2] * inv, acc[nb][3] * inv); *(LAS u32x2*)(Ps + i * 168 + 16 * nb + 4 * fq) = o; }
        f32x4 oa[4]; ZERO_ACC(oa, 4);
#pragma unroll
        for (int ks = 0; ks < 5; ++ks) { const bf16x8 a = *(const LAS bf16x8*)(Ps + i * 168 + ks * 32 + fq * 8);
#pragma unroll
            for (int nb = 0; nb < 4; ++nb) { const bf16x8 bb = tr_frag(Vs, 72, 16 * nb, jstart + 32 * ks, lane); oa[nb] = __builtin_amdgcn_mfma_f32_16x16x32_bf16(bb, a, oa[nb], 0, 0, 0); } }
        bf16_t* op = c.ABR + (size_t)(row0 + i) * KBR + 1536 + hq * 64 + 4 * fq;
#pragma unroll
        for (int nb = 0; nb < 4; ++nb) { u32x2 o; o.x = pk2(oa[nb][0], oa[nb][1]); o.y = pk2(oa[nb][2], oa[nb][3]); *(u32x2*)(op + 16 * nb) = o; }
    }
    __syncthreads();
}

__device__ __forceinline__ void copyp_tile(const Ctx& c, int b) {
    const int tid = otid();
    for (int idx = tid; idx < 3 * 1536; idx += 512) { const int r = idx / 1536, ch = idx % 1536;
        c.out[O_CONVP + ((size_t)(c.l * 8 + b) * 3 + r) * 1536 + ch] = bf2f(c.U[(size_t)(b * PL + PL - 3 + r) * NU + U_XBC + ch]); }
    for (int idx = tid; idx < 128 * 128; idx += 512) { const int j = idx >> 7, ch = idx & 127; const size_t ur = (size_t)(b * PL + PL - 128 + j) * NU;
        c.out[O_KP + ((size_t)(c.l * 8 + b) * 128 + j) * 128 + ch] = bf2f(c.U[ur + U_KC + ch]);
        c.out[O_VP + ((size_t)(c.l * 8 + b) * 128 + j) * 128 + ch] = bf2f(c.U[ur + U_VC + ch]); }
}

__device__ __forceinline__ void sret_tile(const Ctx& c, int item, LAS unsigned char* lds) {
    const int tid = otid(), w = tid >> 6;
    const int h = item & 3, b = item >> 2, row = MPR + b;
    LAS float* qS = (LAS float*)lds; LAS float* kS = qS + 128; LAS float* vS = kS + 128; LAS float* part = vS + 128; LAS float* red = part + 2048;
    const bf16_t* ur = c.U + (size_t)row * NU;
    if (tid < 64) { float cs, sn; rot_cs(PAST_POS, tid, cs, sn);
        const float ql = bf2f(ur[U_QR + h * 128 + tid]), qh = bf2f(ur[U_QR + h * 128 + 64 + tid]), kl = bf2f(ur[U_KR + h * 128 + tid]), kh = bf2f(ur[U_KR + h * 128 + 64 + tid]);
        qS[tid] = ql * cs - qh * sn; qS[64 + tid] = ql * sn + qh * cs; kS[tid] = (kl * cs - kh * sn) * 0.08838834764831845f; kS[64 + tid] = (kl * sn + kh * cs) * 0.08838834764831845f;
    } else if (tid < 192) vS[tid - 64] = bf2f(ur[U_VR + h * 128 + tid - 64]);
    __syncthreads();
    const int v4 = (tid & 31) * 4, dg = tid >> 5; const float gamma = 1.f - exp2f(-5.f - (float)h); const f32x4 vv = *(const LAS f32x4*)(vS + v4);
    const size_t base = ((size_t)(c.l * 128 + b) * 4 + h) * 16384; const float* sin_ = c.in[2] + base; float* sout = c.out + O_RETS + base;
    f32x4 sv[8];
#pragma unroll
    for (int dd = 0; dd < 8; ++dd) sv[dd] = __builtin_nontemporal_load((const f32x4*)(sin_ + (dg * 8 + dd) * 128 + v4));
    f32x4 o = (f32x4){0.f, 0.f, 0.f, 0.f};
#pragma unroll
    for (int dd = 0; dd < 8; ++dd) { const int d = dg * 8 + dd; const f32x4 sn = sv[dd] * gamma + vv * kS[d]; __builtin_nontemporal_store(sn, (f32x4*)(sout + d * 128 + v4)); o += sn * qS[d]; }
    *(LAS f32x4*)(part + dg * 128 + v4) = o;
    __syncthreads();
    float ov = 0.f;
    if (tid < 128) {
#pragma unroll
        for (int k = 0; k < 16; ++k) ov += part[k * 128 + tid];
        const float s = wave_sum(ov); if ((tid & 63) == 0) red[w] = s; }
    __syncthreads();
    const float mean = (red[0] + red[1]) * (1.f / 128.f); const float dv = ov - mean;
    if (tid < 128) { const float s = wave_sum(dv * dv); if ((tid & 63) == 0) red[2 + w] = s; }
    __syncthreads();
    if (tid < 128) { const float rstd = rsqrtf((red[2] + red[3]) * (1.f / 128.f) + EPS); const float gt = siluf_(bf2f(ur[U_GR + h * 128 + tid]));
        c.ABR[(size_t)row * KBR + h * 128 + tid] = (bf16_t)f2bf(dv * rstd * gt); }
    __syncthreads();
}

__device__ __forceinline__ void sssd_tile(const Ctx& c, int item, LAS unsigned char* lds) {
    const int tid = otid(), w = tid >> 6;
    const int g = item & 1, b = item >> 1, row = MPR + b;
    LAS float* xS = (LAS float*)lds; LAS float* BS = xS + 512; LAS float* CS = BS + 128; LAS float* dtv = CS + 128; LAS float* red = dtv + 8;
    const bf16_t* ur = c.U + (size_t)row * NU;
    for (int ch = tid; ch < 768; ch += 512) { const int cb = ch < 512 ? g * 512 + ch : (ch < 640 ? 1024 + g * 128 + (ch - 512) : 1280 + g * 128 + (ch - 640));
        const float* cw = c.in[8] + (size_t)c.l * 4 * 1536 + cb; const float* sc = c.in[4] + (size_t)(c.l * 128 + b) * 3 * 1536 + cb;
        float a = c.in[9][c.l * 1536 + cb] + cw[0] * sc[0] + cw[1536] * sc[1536] + cw[3072] * sc[3072] + cw[4608] * bf2f(ur[U_XBC + cb]);
        xS[ch] = siluf_(a); }
    if (tid < 8) dtv[tid] = softplusf_(bf2f(ur[U_DT + g * 8 + tid]) + c.in[10][c.l * 16 + g * 8 + tid]);
    __syncthreads();
    const int s4 = (tid & 31) * 4, pg = tid >> 5; const f32x4 B4 = *(const LAS f32x4*)(BS + s4), C4 = *(const LAS f32x4*)(CS + s4);
    float ysq = 0.f;
#pragma unroll 2
    for (int hl = 0; hl < 8; ++hl) { const int h = g * 8 + hl; const float dt = dtv[hl], dA = __expf(dt * -__expf(c.in[11][c.l * 16 + h]));
        const size_t base = ((size_t)(c.l * 128 + b) * 16 + h) * 8192; const float* hin = c.in[3] + base; float* hout = c.out + O_SSMS + base;
        f32x4 hv[4];
#pragma unroll
        for (int k = 0; k < 4; ++k) hv[k] = __builtin_nontemporal_load((const f32x4*)(hin + (pg * 4 + k) * 128 + s4));
        float yk[4];
#pragma unroll
        for (int k = 0; k < 4; ++k) { const int p = pg * 4 + k; const f32x4 hn = hv[k] * dA + B4 * (dt * xS[hl * 64 + p]); __builtin_nontemporal_store(hn, (f32x4*)(hout + p * 128 + s4));
            yk[k] = (hn[0] * C4[0] + hn[1] * C4[1]) + (hn[2] * C4[2] + hn[3] * C4[3]); }
#pragma unroll
        for (int o = 1; o < 32; o <<= 1) {
#pragma unroll
            for (int k = 0; k < 4; ++k) yk[k] += __shfl_xor(yk[k], o); }
        if ((tid & 31) == 0) { const float dsk = c.in[12][c.l * 16 + h];
            const u32x2 zv = *(const u32x2*)(ur + U_Z + h * 64 + pg * 4); const float zz[4] = {lo16(zv.x), hi16(zv.x), lo16(zv.y), hi16(zv.y)}; float y[4];
#pragma unroll
            for (int k = 0; k < 4; ++k) { y[k] = (yk[k] + dsk * xS[hl * 64 + pg * 4 + k]) * siluf_(zz[k]); ysq += y[k] * y[k]; }
            u32x2 o; o.x = pk2(y[0], y[1]); o.y = pk2(y[2], y[3]); *(u32x2*)(c.ABR + (size_t)row * KBR + 512 + h * 64 + pg * 4) = o; }
    }
    { const float s = wave_sum(ysq); if ((tid & 63) == 0) red[w] = s; }
    __syncthreads();
    if (tid == 0) { float a = 0.f;
#pragma unroll
        for (int k = 0; k < 8; ++k) a += red[k];
        c.RSTD[row * 2 + g] = rsqrtf(a * (1.f / 512.f) + EPS); }
    __syncthreads();
}

__device__ __forceinline__ void sswa_tile(const Ctx& c, int b, LAS unsigned char* lds) {
    const int tid = otid(), w = tid >> 6, lane = tid & 63, row = MPR + b;
    LAS float* qS = (LAS float*)lds; LAS float* knew = qS + 512; LAS float* vnew = knew + 128; LAS float* pS = vnew + 128;
    const bf16_t* ur = c.U + (size_t)row * NU;
    qS[tid] = bf2f(ur[U_QC + tid]);
    if (tid < 128) knew[tid] = bf2f(ur[U_KC + tid]); else if (tid < 256) vnew[tid - 128] = bf2f(ur[U_VC + tid - 128]);
    __syncthreads();
    const int hq = w, kvh = w >> 2;
    const float* kc = c.in[5] + (size_t)(c.l * 128 + b) * 128 * 128 + kvh * 64; const float* vc = c.in[6] + (size_t)(c.l * 128 + b) * 128 * 128 + kvh * 64;
    float d0 = 0.f, d1 = 0.f, dn = 0.f;
#pragma unroll 4
    for (int d4 = 0; d4 < 16; ++d4) { const f32x4 q = *(const LAS f32x4*)(qS + hq * 64 + d4 * 4), k0 = *(const f32x4*)(kc + (size_t)lane * 128 + d4 * 4), k1 = *(const f32x4*)(kc + (size_t)(lane + 64) * 128 + d4 * 4), kn = *(const LAS f32x4*)(knew + kvh * 64 + d4 * 4);
        d0 += q[0] * k0[0] + q[1] * k0[1] + q[2] * k0[2] + q[3] * k0[3]; d1 += q[0] * k1[0] + q[1] * k1[1] + q[2] * k1[2] + q[3] * k1[3]; dn += q[0] * kn[0] + q[1] * kn[1] + q[2] * kn[2] + q[3] * kn[3]; }
    const float* rb = c.in[15];
    const float l0 = d0 * 0.125f + rb[T5_BUCKET[128 - lane] * 8 + hq], l1 = d1 * 0.125f + rb[T5_BUCKET[64 - lane] * 8 + hq], ln = dn * 0.125f + rb[hq], sink = c.in[14][c.l * 8 + hq];
    const float m = fmaxf(fmaxf(wave_max(fmaxf(l0, l1)), ln), sink);
    const float p0 = __expf(l0 - m), p1 = __expf(l1 - m), pn = __expf(ln - m);
    const float inv = 1.f / (wave_sum(p0 + p1) + pn + __expf(sink - m));
    pS[hq * 132 + lane] = p0 * inv; pS[hq * 132 + 64 + lane] = p1 * inv; if (lane == 0) pS[hq * 132 + 128] = pn * inv;
    __syncthreads();
    float o = pS[hq * 132 + 128] * vnew[kvh * 64 + lane];
#pragma unroll 8
    for (int j = 0; j < 128; ++j) o += pS[hq * 132 + j] * vc[(size_t)j * 128 + lane];
    c.ABR[(size_t)row * KBR + 1536 + hq * 64 + lane] = (bf16_t)f2bf(o);
    const size_t sb = (size_t)(c.l * 128 + b) * 128 * 128; const float* kin = c.in[5] + sb; const float* vin = c.in[6] + sb;
    for (int idx = tid; idx < 128 * 128; idx += 512) { const int j = idx >> 7, ch = idx & 127;
        c.out[O_KS + sb + idx] = j < 127 ? kin[idx + 128] : knew[ch]; c.out[O_VS + sb + idx] = j < 127 ? vin[idx + 128] : vnew[ch]; }
    const size_t cbs = (size_t)(c.l * 128 + b) * 3 * 1536;
    for (int ch = tid; ch < 1536; ch += 512) { c.out[O_CONVS + cbs + ch] = c.in[4][cbs + 1536 + ch]; c.out[O_CONVS + cbs + 1536 + ch] = c.in[4][cbs + 3072 + ch]; c.out[O_CONVS + cbs + 3072 + ch] = bf2f(ur[U_XBC + ch]); }
    __syncthreads();
}

__device__ __forceinline__ void scan_phase(const Ctx& c) {
    const int gt = blockIdx.x * 512 + otid(), NT = gridDim.x * 512;
    for (int i = gt; i < 8 * 4 * 4096; i += NT) { const int e4 = i & 4095, bh = i >> 12, h = bh & 3;
        const float cdec = __expf(__logf(1.f - exp2f(-5.f - (float)h)) * 128.f);
        float* p = c.KV + (size_t)bh * 16 * 16384 + e4 * 4; f32x4 run = (f32x4){0.f, 0.f, 0.f, 0.f}; f32x4 t[16];
#pragma unroll
        for (int n = 0; n < 16; ++n) t[n] = *(const f32x4*)(p + n * 16384);
#pragma unroll
        for (int n = 0; n < 16; ++n) { *(f32x4*)(p + n * 16384) = run; run = run * cdec + t[n]; }
        *(f32x4*)(c.out + O_RETP + ((size_t)c.l * 32 + bh) * 16384 + e4 * 4) = run; }
    for (int i = gt; i < 8 * 16 * 2048; i += NT) { const int e4 = i & 2047, bh = i >> 11, h = bh & 15, b = bh >> 4;
        f32x4 run = (f32x4){0.f, 0.f, 0.f, 0.f}; f32x4 t[16]; float dec[16];
#pragma unroll
        for (int n = 0; n < 16; ++n) { t[n] = *(const f32x4*)(c.ST + ((size_t)((b * 16 + n) * 16 + h)) * 8192 + e4 * 4); dec[n] = __expf(c.CSL[(b * 16 + n) * 16 + h]); }
#pragma unroll
        for (int n = 0; n < 16; ++n) { *(f32x4*)(c.ST + ((size_t)((b * 16 + n) * 16 + h)) * 8192 + e4 * 4) = run; run = run * dec[n] + t[n]; }
        *(f32x4*)(c.out + O_SSMP + ((size_t)c.l * 128 + bh) * 8192 + e4 * 4) = run; }
}

__device__ __forceinline__ void sgemm_accum(f32x4 (&acc)[4], const bf16_t* A, int lda, const bf16_t* Bt, int ldb, int nchunk, LAS unsigned char* lds, int tid, int w, int fr, int fq) {
    u32x4 pa[4], pb[2];
#pragma unroll
    for (int r = 0; r < 4; ++r) { const int unit = tid + 512 * r, kg = unit & 15, j = unit >> 4; pa[r] = *(const u32x4*)(A + (size_t)j * lda + kg * 8); }
#pragma unroll
    for (int r = 0; r < 2; ++r) { const int unit = tid + 512 * r, kg = unit & 15, j = unit >> 4; pb[r] = *(const u32x4*)(Bt + (size_t)j * ldb + kg * 8); }
    for (int cch = 0; cch < nchunk; ++cch) {
        LAS unsigned char* base = lds + (cch & 1) * 52224;
#pragma unroll
        for (int r = 0; r < 4; ++r) { const int unit = tid + 512 * r, kg = unit & 15, j = unit >> 4; *(LAS u32x4*)(base + j * LD136 + kg * 16) = pa[r]; }
#pragma unroll
        for (int r = 0; r < 2; ++r) { const int unit = tid + 512 * r, kg = unit & 15, j = unit >> 4; *(LAS u32x4*)(base + 34816 + j * LD136 + kg * 16) = pb[r]; }
        __syncthreads();
        if (cch + 1 < nchunk) { const int k0 = (cch + 1) * 128;
#pragma unroll
            for (int r = 0; r < 4; ++r) { const int unit = tid + 512 * r, kg = unit & 15, j = unit >> 4; pa[r] = *(const u32x4*)(A + (size_t)j * lda + k0 + kg * 8); }
#pragma unroll
            for (int r = 0; r < 2; ++r) { const int unit = tid + 512 * r, kg = unit & 15, j = unit >> 4; pb[r] = *(const u32x4*)(Bt + (size_t)j * ldb + k0 + kg * 8); } }
        mm_strip<4, 4>(acc, (const LAS unsigned char*)base + w * 16 * LD136, LD136, (const LAS unsigned char*)base + 34816, LD136, fr, fq);
    }
    __syncthreads();
}
__device__ __forceinline__ void sgemm_tile(const Ctx& c, int tile, int mode, const bf16_t* A, const bf16_t* Wt, int K, LAS unsigned char* lds) {
    const int tid = otid(), w = tid >> 6, lane = tid & 63, fr = lane & 15, fq = lane >> 4;
    const int col0 = tile * 64, row = MPR + 16 * w + fr;
    if (mode == 0) {
        f32x4 acc[4]; ZERO_ACC(acc, 4);
        sgemm_accum(acc, A + (size_t)MPR * K, K, Wt + (size_t)col0 * K, K, K / 128, lds, tid, w, fr, fq);
#pragma unroll
        for (int nb = 0; nb < 4; ++nb) { const size_t off = (size_t)row * DM + col0 + 16 * nb + 4 * fq; *(f32x4*)(c.MIX + off) = *(const f32x4*)(c.XF + off) * ALPHA + acc[nb]; }
    } else {
        f32x4 tot[4]; ZERO_ACC(tot, 4);
        for (int br = 0; br < 4; ++br) {
            f32x4 acc[4]; ZERO_ACC(acc, 4);
            sgemm_accum(acc, A + (size_t)MPR * KBR + br * 512, KBR, Wt + (size_t)col0 * KBR + br * 512, KBR, 4, lds, tid, w, fr, fq);
            const int gcol = U_GATE + (br == 0 ? 0 : (br == 3 ? 2048 : 1024));
            float rs = 1.f; if (br == 1) rs = c.RSTD[row * 2]; else if (br == 2) rs = c.RSTD[row * 2 + 1];
#pragma unroll
            for (int nb = 0; nb < 4; ++nb) { const u32x2 gv = *(const u32x2*)(c.U + (size_t)row * NU + gcol + col0 + 16 * nb + 4 * fq);
                tot[nb][0] += rs * sigmoidf_(lo16(gv.x)) * acc[nb][0]; tot[nb][1] += rs * sigmoidf_(hi16(gv.x)) * acc[nb][1];
                tot[nb][2] += rs * sigmoidf_(lo16(gv.y)) * acc[nb][2]; tot[nb][3] += rs * sigmoidf_(hi16(gv.y)) * acc[nb][3]; }
        }
#pragma unroll
        for (int nb = 0; nb < 4; ++nb) { u32x2 o; o.x = pk2(tot[nb][0], tot[nb][1]); o.y = pk2(tot[nb][2], tot[nb][3]); *(u32x2*)(c.MIXB + (size_t)row * DM + col0 + 16 * nb + 4 * fq) = o; }
    }
}

#define XB_TMO      128
#define XB_XCNT(j)  (256  + 64 * (j))
#define XB_XSUB(j)  (1280 + 64 * (j))
#define XB_XGEN(j)  (2304 + 64 * (j))
#define XB_TOP      3328
#define XB_TOPGEN   3392
#define XCD_BAR_WORDS 3456
#define XB_SPIN_CAP (1u << 22)
__device__ __forceinline__ unsigned xb_ld(unsigned* p)              { return __hip_atomic_load(p, __ATOMIC_RELAXED, __HIP_MEMORY_SCOPE_AGENT); }
__device__ __forceinline__ unsigned xb_add(unsigned* p, unsigned v) { return __hip_atomic_fetch_add(p, v, __ATOMIC_RELAXED, __HIP_MEMORY_SCOPE_AGENT); }
__device__ __forceinline__ unsigned xb_xcc_id() { return (unsigned)__builtin_amdgcn_s_getreg((3 << 11) | 20) & 0xFu; }
#define XB_SPIN(cond, bar) do { unsigned _sp = 0; while (cond) { __builtin_amdgcn_s_sleep(1); \
    if ((++_sp & 255u) == 0u) { if (xb_ld(&(bar)[XB_TMO])) break; if (_sp > XB_SPIN_CAP) { atomicAdd(&(bar)[XB_TMO], 1u); break; } } } } while (0)
struct XcdBarrier { unsigned* bar; unsigned x; volatile LAS unsigned* st; };
__device__ __forceinline__ XcdBarrier xcd_barrier_post(unsigned* bar, volatile LAS unsigned* st) {
    XcdBarrier b; b.bar = bar; b.x = xb_xcc_id(); b.st = st;
    if (threadIdx.x == 0) (void)xb_add(&bar[XB_XCNT(b.x)], 1u);
    return b;
}
__device__ __forceinline__ void xcd_barrier_complete(unsigned* bar, unsigned x, unsigned& nloc, unsigned& nx) {
    const unsigned G = gridDim.x * gridDim.y * gridDim.z;
    unsigned sum, cnt, mine, sp = 0u;
    for (;;) {
        sum = 0u; cnt = 0u; mine = 0u;
#pragma unroll
        for (unsigned j = 0; j < 16; ++j) { const unsigned c = xb_ld(&bar[XB_XCNT(j)]); sum += c; cnt += (c > 0u) ? 1u : 0u; mine = (j == x) ? c : mine; }
        if (sum == G) break;
        __builtin_amdgcn_s_sleep(1);
        if ((++sp & 255u) == 0u) { if (xb_ld(&bar[XB_TMO])) break; if (sp > XB_SPIN_CAP) { atomicAdd(&bar[XB_TMO], 1u); break; } }
    }
    nloc = mine > 0u ? mine : 1u; nx = cnt > 0u ? cnt : 1u;
}
__device__ __forceinline__ void xcd_barrier(const XcdBarrier& b) {
    asm volatile("s_waitcnt vmcnt(0)" ::: "memory");
    __syncthreads();
    if (threadIdx.x == 0) {
        unsigned* bar = b.bar;
        __builtin_amdgcn_s_waitcnt(0);
        unsigned nloc = b.st[0], nx = b.st[1];
        if (nloc == 0u) { xcd_barrier_complete(bar, b.x, nloc, nx); b.st[0] = nloc; b.st[1] = nx; }
        const unsigned old = xb_add(&bar[XB_XSUB(b.x)], 1u);
        const unsigned gen = old / nloc;
        if (old + 1u == (gen + 1u) * nloc) {
            __builtin_amdgcn_fence(__ATOMIC_RELEASE, "agent");
            asm volatile("s_waitcnt vmcnt(0)" ::: "memory");
            const unsigned og = xb_add(&bar[XB_TOP], 1u);
            const unsigned tg = og / nx;
            if (og + 1u == (tg + 1u) * nx) xb_add(&bar[XB_TOPGEN], 1u);
            else XB_SPIN(xb_ld(&bar[XB_TOPGEN]) == tg, bar);
            __builtin_amdgcn_fence(__ATOMIC_ACQUIRE, "agent");
            xb_add(&bar[XB_XGEN(b.x)], 1u);
            asm volatile("s_waitcnt vmcnt(0)" ::: "memory");
        } else {
            XB_SPIN(xb_ld(&bar[XB_XGEN(b.x)]) == gen, bar);
            __builtin_amdgcn_fence(__ATOMIC_ACQUIRE, "agent");
            asm volatile("s_waitcnt vmcnt(0)" ::: "memory");
        }
    }
    __syncthreads();
}

constexpr int N_PHASES = 1 + NLAYER * 10;
#ifndef DISMASK
#define DISMASK 0
#endif
#ifndef REPMASK
#define REPMASK 0
#endif
#ifndef TREP
#define TREP 0
#endif
#define DIS(bit, stmt) do { if (!((DISMASK) & (bit))) { stmt; if ((TREP) & (bit)) { stmt; } } } while (0)
__global__ void __launch_bounds__(512, 2) mega_fwd(Args a) {
    extern __shared__ __attribute__((aligned(16))) unsigned char lds_raw[];
    LAS unsigned char* lds = (LAS unsigned char*)lds_raw;
    cg::grid_group grid = cg::this_grid();
    Ctx c; c.in = a.in; c.out = a.out; c.ws = a.ws;
    c.XB = (bf16_t*)(a.ws + WS_XB); c.XF = (float*)(a.ws + WS_XF); c.U = (bf16_t*)(a.ws + WS_U); c.H = (bf16_t*)(a.ws + WS_U); c.ABR = (bf16_t*)(a.ws + WS_ABR);
    c.MIX = (float*)(a.ws + WS_MIX); c.MIXB = (bf16_t*)(a.ws + WS_MIXB); c.KV = (float*)(a.ws + WS_KV); c.ST = (float*)(a.ws + WS_ST); c.CSL = (float*)(a.ws + WS_CSL); c.RSTD = (float*)(a.ws + WS_RSTD); c.XBCC = (bf16_t*)(a.ws + WS_XBCC);
    const int G = gridDim.x, bx = blockIdx.x;
    volatile LAS unsigned* bst = (volatile LAS unsigned*)(lds + LDS_BYTES - 16);
    if (threadIdx.x < 4) bst[threadIdx.x] = 0u;
    __syncthreads();
    XcdBarrier xbar = xcd_barrier_post((unsigned*)(a.ws + WS_CTL), bst);
    int rep = 0;
    for (int ph = a.ph_lo; ph < a.ph_hi; ++ph) {
        if (ph == 0) { c.l = 0; DIS(1024, prologue(c, lds)); }
        else {
            const int l = (ph - 1) / 10, s = (ph - 1) % 10; c.l = l;
            if (s == 0) {
                pg8::Gemm g{c.XB, wl(a.ws, l, OFF_WIN), MP, NU, DM, DM, DM}; pg8::StaticOrder S; S.init(MP, NU, G, bx);
                EpiBf16 E{c.U, NU}; DIS(2048, (pg8::gemm_phase<EpiBf16, true>(lds, g, S, E)));
            } else if (s == 1) {
                for (int it = bx; it < 1928; it += G) {
                    if (it < 256) { DIS(1, swa_tile(c, it, lds)); }
                    else if (it < 512) { DIS(2, ssd1_tile(c, it - 256, lds)); }
                    else if (it < 1024) { DIS(4, ret1_tile(c, it - 512, lds)); }
                    else if (it < 1536) { DIS(8, sret_tile(c, it - 1024, lds)); }
                    else if (it < 1792) { DIS(16, sssd_tile(c, it - 1536, lds)); }
                    else if (it < 1920) { DIS(32, sswa_tile(c, it - 1792, lds)); }
                    else { DIS(64, copyp_tile(c, it - 1920)); }
                }
            } else if (s == 2) { DIS(512, scan_phase(c)); }
            else if (s == 3) {
                for (int it = bx; it < 768; it += G) { if (it < 256) { DIS(128, ssd2_tile(c, it, lds)); } else { DIS(256, ret2_tile(c, it - 256, lds)); } }
            } else if (s == 4) {
                for (int br = 0; br < 4; ++br) {
                    pg8::Gemm g{c.ABR + br * 512, wl(a.ws, l, OFF_WBR) + br * 512, MPR, DM, 512, KBR, KBR}; pg8::StaticOrder S; S.init(MPR, DM, G, bx);
                    EpiBranch E{c.U, c.RSTD, c.MIX, c.MIXB, br}; DIS(4096, (pg8::gemm_phase<EpiBranch, true>(lds, g, S, E)));
                }
                for (int t = bx; t < 16; t += G) sgemm_tile(c, t, 1, c.ABR, wl(a.ws, l, OFF_WBR), KBR, lds);
            } else if (s == 5 || s == 8) {
                const bf16_t* Aop = s == 5 ? c.MIXB : c.H; const bf16_t* Wop = wl(a.ws, l, s == 5 ? OFF_WOUT : OFF_WDN); const int Kop = s == 5 ? DM : DFF;
                pg8::Gemm g{Aop, Wop, MPR, DM, Kop, Kop, Kop}; pg8::StaticOrder S; S.init(MPR, DM, G, bx);
                EpiRes E{c.XF, c.MIX}; DIS(8192, (pg8::gemm_phase<EpiRes, true>(lds, g, S, E)));
                for (int t = bx; t < 16; t += G) sgemm_tile(c, t, 0, Aop, Wop, Kop, lds);
            } else if (s == 6 || s == 9) {
                const bool fin = (s == 9 && l == NLAYER - 1);
                DIS(32768, ln_phase(c, c.in[s == 6 ? 20 : 22] + l * DM, c.in[s == 6 ? 21 : 23] + l * DM, fin));
            } else {
                pg8::Gemm g{c.XB, wl(a.ws, l, OFF_WGU), MP, 2 * DFF, DM, DM, DM}; pg8::StaticOrder S; S.init(MP, 2 * DFF, G, bx);
                EpiGU E{c.H}; DIS(16384, (pg8::gemm_phase<EpiGU, true>(lds, g, S, E)));
            }
        }
        if (ph + 1 < a.ph_hi) { if (ph == 0 && rep == 0) grid.sync(); else xcd_barrier(xbar); }
        if (REPMASK) { const int sidx = ph == 0 ? 10 : (ph - 1) % 10; if (((REPMASK) >> sidx & 1) && rep == 0) { rep = 1; --ph; } else rep = 0; }
    }
}

#ifndef MK_PER_PHASE
#define MK_PER_PHASE 0
#endif
extern "C" void kernel_launch(void* const* d_in, const int* in_sizes, int n_in, void* d_out, int out_size, void* d_ws, size_t ws_size, hipStream_t stream) {
    static int grid = 0;
    if (grid == 0) {
        if (n_in != 27 || (size_t)out_size != O_END || ws_size < WS_END) { fprintf(stderr, "kernel_launch: unexpected shapes: n_in %d out %d (want %zu) ws %zu (want %zu)\n", n_in, out_size, (size_t)O_END, ws_size, (size_t)WS_END); grid = -1; return; }
        int dev = 0, cus = 0, per_cu = 0;
        (void)hipGetDevice(&dev); (void)hipDeviceGetAttribute(&cus, hipDeviceAttributeMultiprocessorCount, dev);
        if (hipFuncSetAttribute((const void*)mega_fwd, hipFuncAttributeMaxDynamicSharedMemorySize, LDS_BYTES) != hipSuccess) { fprintf(stderr, "kernel_launch: hipFuncSetAttribute failed\n"); grid = -1; return; }
        if (hipOccupancyMaxActiveBlocksPerMultiprocessor(&per_cu, (const void*)mega_fwd, 512, LDS_BYTES) != hipSuccess || per_cu < 1) { fprintf(stderr, "kernel_launch: occupancy query says %d\n", per_cu); per_cu = 1; }
        (void)hipGetLastError();
        grid = cus * per_cu;
    }
    if (grid < 0) return;
    if (hipMemsetAsync((char*)d_ws + WS_CTL, 0, CTL_BYTES, stream) != hipSuccess) { fprintf(stderr, "kernel_launch: memset failed\n"); return; }
    Args a{};
    for (int i = 0; i < 27; ++i) a.in[i] = (const float*)d_in[i];
    a.out = (float*)d_out; a.ws = (unsigned char*)d_ws;
#if MK_PER_PHASE
    for (int ph = 0; ph < N_PHASES; ++ph) { a.ph_lo = ph; a.ph_hi = ph + 1; hipLaunchKernelGGL(mega_fwd, dim3(grid), dim3(512), LDS_BYTES, stream, a); }
#else
    a.ph_lo = 0; a.ph_hi = N_PHASES;
    void* args[] = {&a};
    hipError_t e = hipLaunchCooperativeKernel((const void*)mega_fwd, dim3(grid), dim3(512), args, LDS_BYTES, stream);
    if (e != hipSuccess) fprintf(stderr, "cooperative launch failed: %s (grid %d)\n", hipGetErrorString(e), grid);
#endif
}
```
